# Optimizing an MI355X kernel written in HIP

```python
import math
import jax, jax.numpy as jnp
from jax import lax
import numpy as np

D_MODEL = 1024
BATCH = 8
SEQ = 2048
DEPTH = 4

CTX_LEN = 256
GRID_W = 64
MLA_HEADS = 8
MLA_NOPE = 64
MLA_ROPE = 32
MLA_V = 64
MLA_QK = MLA_NOPE + MLA_ROPE
Q_LORA = 768
KV_LORA = 256
NA_HEADS = 8
NA_DIM = 64
NA_KH = 8
NA_KW = 16
D_FF = 4 * D_MODEL
N_BRANCH = 2
ROPE_BASE = 10000.0
ROPE_PAIRS = MLA_ROPE // 4
EPS = 1e-6
Q_BLOCK = 128
OFF_CQ = N_BRANCH * D_MODEL
OFF_CKV = OFF_CQ + Q_LORA
OFF_KR = OFF_CKV + KV_LORA
OFF_NA = OFF_KR + MLA_ROPE
IN_COLS = OFF_NA + 3 * NA_HEADS * NA_DIM

kernel_name = "hybrid_mla_natten_dit_trunk"


def rms_norm(x, g):
    xf = x.astype(jnp.float32)
    y = xf * lax.rsqrt(jnp.mean(xf * xf, axis=-1, keepdims=True) + EPS)
    return (y * g.astype(jnp.float32)).astype(x.dtype)


def modulate(h, shift, scale):
    return h * (1 + scale) + shift


def rope_half(x, ang):
    m = x.shape[-1] // 2
    x1, x2 = x[..., :m], x[..., m:]
    cos = jnp.cos(ang).astype(x.dtype)
    sin = jnp.sin(ang).astype(x.dtype)
    return jnp.concatenate([x1 * cos - x2 * sin, x1 * sin + x2 * cos], axis=-1)


def rope_2d(x, ang_r, ang_c):
    half = x.shape[-1] // 2
    return jnp.concatenate([rope_half(x[..., :half], ang_r), rope_half(x[..., half:], ang_c)], axis=-1)


def mixer_proj(h, w_in, g_qa, w_uq, g_kva, w_ukv, g_mq, g_mk, g_nq, g_nk):
    b_, s_ = h.shape[0], h.shape[1]
    p = h @ w_in
    gate_logits = p[..., :OFF_CQ]
    c_q = p[..., OFF_CQ:OFF_CKV]
    c_kv = p[..., OFF_CKV:OFF_KR]
    k_r = p[..., OFF_KR:OFF_NA]
    na = p[..., OFF_NA:].reshape(b_, s_, 3, NA_HEADS, NA_DIM)
    mq = (rms_norm(c_q, g_qa) @ w_uq).reshape(b_, s_, MLA_HEADS, MLA_QK)
    kv = (rms_norm(c_kv, g_kva) @ w_ukv).reshape(b_, s_, MLA_HEADS, MLA_NOPE + MLA_V)
    k_nope, mv = kv[..., :MLA_NOPE], kv[..., MLA_NOPE:]
    k_rope = jnp.broadcast_to(k_r[:, :, None, :], (b_, s_, MLA_HEADS, MLA_ROPE))
    mk = jnp.concatenate([k_nope, k_rope], axis=-1)
    mq = rms_norm(mq, g_mq)
    mk = rms_norm(mk, g_mk)
    nq = rms_norm(na[:, :, 0], g_nq)
    nk = rms_norm(na[:, :, 1], g_nk)
    nv = na[:, :, 2]
    return gate_logits, mq, mk, mv, nq, nk, nv


def dense_attention(q, k, v):
    scale = 1.0 / math.sqrt(q.shape[-1])
    s = jnp.einsum("bqhd,bkhd->bhqk", q, k).astype(jnp.float32) * scale
    p = jax.nn.softmax(s, axis=-1).astype(v.dtype)
    return jnp.einsum("bhqk,bkhe->bqhe", p, v)


def blocked_attention(q, k, v):
    b_, s_, h_, d_ = q.shape
    nb = s_ // Q_BLOCK
    qb = jnp.moveaxis(q.reshape(b_, nb, Q_BLOCK, h_, d_), 1, 0)
    ob = lax.map(lambda blk: dense_attention(blk, k, v), qb)
    return jnp.moveaxis(ob, 0, 1).reshape(b_, s_, h_, v.shape[-1])


def neighborhood_attention(q, k, v, k_ctx, v_ctx, rpb):
    b_, s_, h_, d_ = q.shape
    rows = s_ // GRID_W
    kh = min(NA_KH, rows)
    kw = NA_KW
    scale = 1.0 / math.sqrt(d_)
    to_grid = lambda t: t.reshape(b_, rows, GRID_W, h_, d_).transpose(1, 0, 3, 2, 4)
    q_g, k_g, v_g = to_grid(q), to_grid(k), to_grid(v)
    cols = jnp.arange(GRID_W)
    c_start = jnp.clip(cols - kw // 2, 0, GRID_W - kw)
    col_idx = c_start[:, None] + jnp.arange(kw)[None, :]
    dc_idx = col_idx - cols[:, None] + (NA_KW - 1)
    rpb_cols = rpb[:, :, dc_idx]

    def row_fn(args):
        q_r, r = args
        r_start = jnp.clip(r - kh // 2, 0, rows - kh)
        k_rows = lax.dynamic_slice_in_dim(k_g, r_start, kh, axis=0)
        v_rows = lax.dynamic_slice_in_dim(v_g, r_start, kh, axis=0)
        k_win = k_rows[:, :, :, col_idx]
        v_win = v_rows[:, :, :, col_idx]
        dr_idx = r_start + jnp.arange(kh) - r + (NA_KH - 1)
        bias = jnp.transpose(jnp.take(rpb_cols, dr_idx, axis=1), (0, 2, 1, 3))
        s_win = jnp.einsum("bhqd,ibhqjd->bhqij", q_r, k_win).astype(jnp.float32) * scale
        s_win = (s_win + bias.astype(jnp.float32)).reshape(b_, h_, GRID_W, kh * kw)
        s_ctx = jnp.einsum("bhqd,bkhd->bhqk", q_r, k_ctx).astype(jnp.float32) * scale
        p = jax.nn.softmax(jnp.concatenate([s_win, s_ctx], axis=-1), axis=-1).astype(v.dtype)
        p_win = p[..., :kh * kw].reshape(b_, h_, GRID_W, kh, kw)
        p_ctx = p[..., kh * kw:]
        return (jnp.einsum("bhqij,ibhqjd->bhqd", p_win, v_win)
                + jnp.einsum("bhqk,bkhd->bhqd", p_ctx, v_ctx))

    o = lax.map(row_fn, (q_g, jnp.arange(rows)))
    return o.transpose(1, 0, 3, 2, 4).reshape(b_, s_, h_ * d_)


def gated_merge(gate_logits, y_mla, y_na, w_mla_o, w_na_o, w_out):
    g = jax.nn.sigmoid(gate_logits.astype(jnp.float32)).astype(y_mla.dtype)
    y = g[..., :D_MODEL] * (y_mla @ w_mla_o) + g[..., D_MODEL:] * (y_na @ w_na_o)
    return y @ w_out


def squared_relu_mlp(h, w_ff1, w_ff2):
    return jnp.square(jax.nn.relu(h @ w_ff1)) @ w_ff2


def _normal(key, shape, scale):
    return jax.random.normal(key, shape, jnp.float32) * scale


def setup_inputs(seed: int = 0) -> dict:
    key = jax.random.key(seed)
    ks = jax.random.split(key, 24)
    L = DEPTH
    gain = lambda k, n: 1.0 + _normal(k, (L, n), 0.1)
    return {
        "x": _normal(ks[0], (BATCH, SEQ, D_MODEL), 1.0),
        "c": _normal(ks[1], (BATCH, D_MODEL), 1.0),
        "ctx": _normal(ks[2], (BATCH, CTX_LEN, D_MODEL), 1.0),
        "c_ctx": _normal(ks[3], (D_MODEL,), 1.0),
        "w_ada": _normal(ks[4], (L, D_MODEL, 6 * D_MODEL), D_MODEL ** -0.5),
        "b_ada": _normal(ks[5], (L, 6 * D_MODEL), 0.02),
        "g_attn": gain(ks[6], D_MODEL),
        "w_in": _normal(ks[7], (L, D_MODEL, IN_COLS), D_MODEL ** -0.5),
        "g_qa": gain(ks[8], Q_LORA),
        "w_uq": _normal(ks[9], (L, Q_LORA, MLA_HEADS * MLA_QK), Q_LORA ** -0.5),
        "g_kva": gain(ks[10], KV_LORA),
        "w_ukv": _normal(ks[11], (L, KV_LORA, MLA_HEADS * (MLA_NOPE + MLA_V)), KV_LORA ** -0.5),
        "g_mla_q": gain(ks[12], MLA_QK),
        "g_mla_k": gain(ks[13], MLA_QK),
        "g_na_q": gain(ks[14], NA_DIM),
        "g_na_k": gain(ks[15], NA_DIM),
        "rpb": _normal(ks[16], (L, NA_HEADS, 2 * NA_KH - 1, 2 * NA_KW - 1), 0.1),
        "w_mla_o": _normal(ks[17], (L, MLA_HEADS * MLA_V, D_MODEL), (MLA_HEADS * MLA_V) ** -0.5),
        "w_na_o": _normal(ks[18], (L, NA_HEADS * NA_DIM, D_MODEL), (NA_HEADS * NA_DIM) ** -0.5),
        "w_out": _normal(ks[19], (L, D_MODEL, D_MODEL), D_MODEL ** -0.5),
        "g_mlp": gain(ks[20], D_MODEL),
        "w_ff1": _normal(ks[21], (L, D_MODEL, D_FF), D_MODEL ** -0.5),
        "w_ff2": _normal(ks[22], (L, D_FF, D_MODEL), D_FF ** -0.5),
    }


def reference(x, c, ctx, c_ctx, w_ada, b_ada, g_attn, w_in, g_qa, w_uq, g_kva, w_ukv,
              g_mla_q, g_mla_k, g_na_q, g_na_k, rpb, w_mla_o, w_na_o, w_out,
              g_mlp, w_ff1, w_ff2):
    b_, s_, _ = x.shape
    l_ = ctx.shape[1]
    t = jnp.arange(s_)
    inv_freq = ROPE_BASE ** (-jnp.arange(ROPE_PAIRS, dtype=jnp.float32) / ROPE_PAIRS)
    ang_r = ((t // GRID_W).astype(jnp.float32)[:, None] * inv_freq)[:, None, :]
    ang_c = ((t % GRID_W).astype(jnp.float32)[:, None] * inv_freq)[:, None, :]
    silu_c = jax.nn.silu(c)
    silu_ctx = jax.nn.silu(c_ctx)
    x_lat, x_ctx = x, ctx
    for l in range(DEPTH):
        last = l == DEPTH - 1
        mod_lat = (silu_c @ w_ada[l] + b_ada[l])[:, None, :]
        mod_ctx = silu_ctx @ w_ada[l] + b_ada[l]
        sh1, sc1, gt1, sh2, sc2, gt2 = jnp.split(mod_lat, 6, axis=-1)
        csh1, csc1, cgt1, csh2, csc2, cgt2 = jnp.split(mod_ctx, 6, axis=-1)
        proj_w = (w_in[l], g_qa[l], w_uq[l], g_kva[l], w_ukv[l],
                  g_mla_q[l], g_mla_k[l], g_na_q[l], g_na_k[l])

        h_c = modulate(rms_norm(x_ctx, g_attn[l]), csh1, csc1)
        gl_c, mq_c, mk_c, mv_c, nq_c, nk_c, nv_c = mixer_proj(h_c, *proj_w)

        h = modulate(rms_norm(x_lat, g_attn[l]), sh1, sc1)
        gl, mq, mk, mv, nq, nk, nv = mixer_proj(h, *proj_w)
        mq = jnp.concatenate([mq[..., :MLA_NOPE], rope_2d(mq[..., MLA_NOPE:], ang_r, ang_c)], axis=-1)
        mk = jnp.concatenate([mk[..., :MLA_NOPE], rope_2d(mk[..., MLA_NOPE:], ang_r, ang_c)], axis=-1)
        y_mla = blocked_attention(mq, jnp.concatenate([mk_c, mk], axis=1),
                                  jnp.concatenate([mv_c, mv], axis=1)).reshape(b_, s_, MLA_HEADS * MLA_V)
        y_na = neighborhood_attention(nq, nk, nv, nk_c, nv_c, rpb[l])
        x_lat = x_lat + gt1 * gated_merge(gl, y_mla, y_na, w_mla_o[l], w_na_o[l], w_out[l])

        if not last:
            y_mla_c = dense_attention(mq_c, mk_c, mv_c).reshape(b_, l_, MLA_HEADS * MLA_V)
            y_na_c = dense_attention(nq_c, nk_c, nv_c).reshape(b_, l_, NA_HEADS * NA_DIM)
            x_ctx = x_ctx + cgt1 * gated_merge(gl_c, y_mla_c, y_na_c, w_mla_o[l], w_na_o[l], w_out[l])
            h2_c = modulate(rms_norm(x_ctx, g_mlp[l]), csh2, csc2)
            x_ctx = x_ctx + cgt2 * squared_relu_mlp(h2_c, w_ff1[l], w_ff2[l])

        h2 = modulate(rms_norm(x_lat, g_mlp[l]), sh2, sc2)
        x_lat = x_lat + gt2 * squared_relu_mlp(h2, w_ff1[l], w_ff2[l])
    return x_lat
```

```cpp
#include <hip/hip_runtime.h>
#include <hip/hip_cooperative_groups.h>
#include <cstdio>
namespace cg = cooperative_groups;

typedef unsigned short bf16_t;
typedef short bf16x8 __attribute__((ext_vector_type(8)));
typedef float f32x4 __attribute__((ext_vector_type(4)));
typedef unsigned u32x4 __attribute__((ext_vector_type(4)));
typedef unsigned u32x2 __attribute__((ext_vector_type(2)));
#define DI __device__ __forceinline__

constexpr int DM = 1024, NBATCH = 8, SEQ = 2048, CTXL = 256, TPB = 2304, TT = 18432, NLAYER = 4;
constexpr int NRT = TT / 128;
constexpr int INC = 4640;
constexpr int PBW = 2688;
constexpr int QKW = 1792;
constexpr float EPS = 1e-6f;
constexpr float LOG2E = 1.4426950408889634f;

constexpr size_t al256(size_t x) { return (x + 255) & ~(size_t)255; }
constexpr size_t O_WG   = 0;
constexpr size_t O_WP   = O_WG   + (size_t)2048 * 1024 * 2;
constexpr size_t O_WUQ  = O_WP   + (size_t)PBW * 1024 * 2;
constexpr size_t O_WUKV = O_WUQ  + (size_t)768 * 768 * 2;
constexpr size_t O_WMO  = O_WUKV + (size_t)1024 * 256 * 2;
constexpr size_t O_WNO  = O_WMO  + (size_t)1024 * 512 * 2;
constexpr size_t O_WOUT = O_WNO  + (size_t)1024 * 512 * 2;
constexpr size_t O_WFF1 = O_WOUT + (size_t)1024 * 1024 * 2;
constexpr size_t O_WFF2 = O_WFF1 + (size_t)4096 * 1024 * 2;
constexpr size_t O_MOD  = O_WFF2 + (size_t)4096 * 1024 * 2;
constexpr size_t O_TAB  = al256(O_MOD + (size_t)4 * 9 * 6144 * 4);
constexpr size_t O_STAT = al256(O_TAB + 64 * 8 * 2 * 4);
constexpr size_t O_XCTX = al256(O_STAT + (size_t)TT * 2 * 4);
constexpr size_t O_HB   = al256(O_XCTX + (size_t)2048 * 1024 * 4);
constexpr size_t O_PB   = al256(O_HB + (size_t)TT * 1024 * 2);
constexpr size_t O_QK2  = O_PB + (size_t)TT * PBW * 2;
constexpr size_t O_R2   = al256(O_QK2 + (size_t)TT * QKW * 2);
constexpr size_t O_MQ   = O_R2;
constexpr size_t O_MK   = O_MQ + (size_t)TT * 768 * 2;
constexpr size_t O_MVT  = O_MK + (size_t)TT * 768 * 2;
constexpr size_t O_NQ   = O_MVT + (size_t)TT * 512 * 2;
constexpr size_t O_NK   = O_NQ + (size_t)TT * 512 * 2;
constexpr size_t O_NVT  = O_NK + (size_t)TT * 512 * 2;
constexpr size_t O_END  = O_NVT + (size_t)TT * 512 * 2;
constexpr size_t O_YMLA = O_QK2;
constexpr size_t O_YNA  = O_QK2 + (size_t)TT * 512 * 2;
constexpr size_t O_Y    = O_MQ;
constexpr size_t O_HID  = O_PB;

struct Params {
  const float *x, *c, *ctx, *c_ctx, *w_ada, *b_ada, *g_attn, *w_in, *g_qa, *w_uq, *g_kva, *w_ukv, *g_mla_q, *g_mla_k, *g_na_q, *g_na_k, *rpb,
      *w_mla_o, *w_na_o, *w_out, *g_mlp, *w_ff1, *w_ff2;
  float* out;
  char* ws;
};

typedef float f32x2_t __attribute__((ext_vector_type(2)));
typedef __bf16 bf16x2_t __attribute__((ext_vector_type(2)));
DI unsigned cvt_pk_bf16(float lo, float hi) { f32x2_t v = {lo, hi}; bf16x2_t b = __builtin_convertvector(v, bf16x2_t); return __builtin_bit_cast(unsigned, b); }
DI bf16_t f2bf(float x) { unsigned u = __float_as_uint(x); u += 0x7fffu + ((u >> 16) & 1u); return (bf16_t)(u >> 16); }
DI float bflo(unsigned u) { return __uint_as_float(u << 16); }
DI float bfhi(unsigned u) { return __uint_as_float(u & 0xffff0000u); }
DI int otid() { int t = threadIdx.x; asm volatile("" : "+v"(t)); return t; }
DI float wave_sum(float v) {
#pragma unroll
  for (int o = 32; o >= 1; o >>= 1) v += __shfl_xor(v, o);
  return v;
}
DI float* xrow_ptr(const Params& p, int urow) {
  const int b = urow / TPB, t = urow - b * TPB;
  return t < CTXL ? (float*)(p.ws + O_XCTX) + ((size_t)(b * CTXL + t)) * DM : p.out + ((size_t)(b * SEQ + t - CTXL)) * DM;
}
DI int modrow_of(int urow) { const int b = urow / TPB, t = urow - b * TPB; return t < CTXL ? 8 : b; }

template <int NT>
DI void gemm_main(const bf16_t* __restrict__ A, int lda, const bf16_t* __restrict__ Bt, int ldb, int K, char* smem, f32x4 (&acc)[4][NT]) {
  const int tid = otid(), lane = tid & 63, w = tid >> 6, wr = w >> 1, wc = w & 1, fr = lane & 15, fq = lane >> 4;
  const int lr = tid >> 3, lch = tid & 7;
  const bf16_t* ga = A + (size_t)lr * lda + lch * 8;
  const bf16_t* gb = Bt + (size_t)lr * ldb + lch * 8;
  const int wofs = lr * 128 + ((lch ^ (lr & 7)) << 4);
  u32x4 ra[4], rb[NT];
#pragma unroll
  for (int i = 0; i < 4; ++i) ra[i] = *(const u32x4*)(ga + (size_t)i * 32 * lda);
#pragma unroll
  for (int i = 0; i < NT; ++i) rb[i] = *(const u32x4*)(gb + (size_t)i * 32 * ldb);
#pragma unroll
  for (int i = 0; i < 4; ++i) *(u32x4*)(smem + wofs + i * 4096) = ra[i];
#pragma unroll
  for (int i = 0; i < NT; ++i) *(u32x4*)(smem + 16384 + wofs + i * 4096) = rb[i];
  __syncthreads();
  const int nt = K >> 6;
  const int aofs = (wr * 64 + fr) * 128;
  const int bofs = 16384 + (wc * NT * 16 + fr) * 128;
  const int sw = fr & 7;
  for (int kt = 0; kt < nt; ++kt) {
    const int cur = (kt & 1) * 32768;
    const bool more = (kt + 1 < nt);
    if (more) {
      const int ko = (kt + 1) * 64;
#pragma unroll
      for (int i = 0; i < 4; ++i) ra[i] = *(const u32x4*)(ga + (size_t)i * 32 * lda + ko);
#pragma unroll
      for (int i = 0; i < NT; ++i) rb[i] = *(const u32x4*)(gb + (size_t)i * 32 * ldb + ko);
    }
#pragma unroll
    for (int kk = 0; kk < 2; ++kk) {
      bf16x8 af[4], bfr[NT];
      const int ch = ((kk * 4 + fq) ^ sw) << 4;
#pragma unroll
      for (int m = 0; m < 4; ++m) af[m] = *(const bf16x8*)(smem + cur + aofs + m * 2048 + ch);
#pragma unroll
      for (int n = 0; n < NT; ++n) bfr[n] = *(const bf16x8*)(smem + cur + bofs + n * 2048 + ch);
#pragma unroll
      for (int m = 0; m < 4; ++m)
#pragma unroll
        for (int n = 0; n < NT; ++n) acc[m][n] = __builtin_amdgcn_mfma_f32_16x16x32_bf16(bfr[n], af[m], acc[m][n], 0, 0, 0);
    }
    if (more) {
      const int nxt = cur ^ 32768;
#pragma unroll
      for (int i = 0; i < 4; ++i) *(u32x4*)(smem + nxt + wofs + i * 4096) = ra[i];
#pragma unroll
      for (int i = 0; i < NT; ++i) *(u32x4*)(smem + nxt + 16384 + wofs + i * 4096) = rb[i];
    }
    __syncthreads();
  }
}
template <int NT>
DI void acc_zero(f32x4 (&acc)[4][NT]) {
#pragma unroll
  for (int m = 0; m < 4; ++m)
#pragma unroll
    for (int n = 0; n < NT; ++n) acc[m][n] = (f32x4){0.f, 0.f, 0.f, 0.f};
}
template <int ACT  , int NT>
DI void store_bf16_tile(const f32x4 (&acc)[4][NT], bf16_t* O, int ldo) {
  const int tid_ = otid(), lane = tid_ & 63, w = tid_ >> 6, wr = w >> 1, wc = w & 1, fr = lane & 15, fq = lane >> 4;
#pragma unroll
  for (int m = 0; m < 4; ++m)
#pragma unroll
    for (int n = 0; n < NT; ++n) {
      f32x4 v = acc[m][n];
      if (ACT == 1) {
#pragma unroll
        for (int j = 0; j < 4; ++j) { float r = fmaxf(v[j], 0.f); v[j] = r * r; }
      }
      u32x2 pk; pk.x = cvt_pk_bf16(v[0], v[1]); pk.y = cvt_pk_bf16(v[2], v[3]);
      *(u32x2*)(O + (size_t)(wr * 64 + m * 16 + fr) * ldo + wc * NT * 16 + n * 16 + fq * 4) = pk;
    }
}
DI void residual_tile(const f32x4 (&acc)[4][4], float* X, const float* gate) {
  const int tid_ = otid(), lane = tid_ & 63, w = tid_ >> 6, wr = w >> 1, wc = w & 1, fr = lane & 15, fq = lane >> 4;
#pragma unroll
  for (int n = 0; n < 4; ++n) {
    const f32x4 g = *(const f32x4*)(gate + wc * 64 + n * 16 + fq * 4);
#pragma unroll
    for (int m = 0; m < 4; ++m) {
      float* px = X + (size_t)(wr * 64 + m * 16 + fr) * DM + wc * 64 + n * 16 + fq * 4;
      f32x4 xv = *(const f32x4*)px;
      xv = xv + g * acc[m][n];
      *(f32x4*)px = xv;
    }
  }
}

struct ConvDesc { const float* src; int ld, col0, K, N; bf16_t* dst; int ldd; const float* scale; };
DI void conv_tile(const ConvDesc& d, int ti, char* smem) {
  float* tile = (float*)smem;
  const int nkt = d.K >> 6;
  const int k0 = (ti % nkt) * 64, n0 = (ti / nkt) * 64;
  const int tid = otid();
#pragma unroll 4
  for (int i = 0; i < 16; ++i) {
    const int idx = tid + i * 256, kk = idx >> 6, nn = idx & 63;
    float v = 0.f;
    if (n0 + nn < d.N) v = d.src[(size_t)(k0 + kk) * d.ld + d.col0 + n0 + nn];
    if (d.scale) v *= d.scale[k0 + kk];
    tile[kk * 65 + nn] = v;
  }
  __syncthreads();
#pragma unroll 4
  for (int i = 0; i < 16; ++i) {
    const int idx = tid + i * 256, nn = idx >> 6, kk = idx & 63;
    if (n0 + nn < d.N) d.dst[(size_t)(n0 + nn) * d.ldd + k0 + kk] = f2bf(tile[kk * 65 + nn]);
  }
  __syncthreads();
}
DI void convert_weights(const Params& p, int l, char* smem) {
  char* ws = p.ws;
  const float* win = p.w_in + (size_t)l * DM * INC;
  const int cnt[12] = {16 * 32, 16 * 12, 16 * 4, 16 * 24, 16 * 1, 12 * 12, 4 * 16, 8 * 16, 8 * 16, 16 * 16, 16 * 64, 64 * 16};
  int total = 0;
#pragma unroll
  for (int i = 0; i < 12; ++i) total += cnt[i];
  for (int t = blockIdx.x; t < total; t += gridDim.x) {
    int which = 0, rem = t;
#pragma unroll
    for (int i = 0; i < 12; ++i) { if (which == i && rem >= cnt[i]) { rem -= cnt[i]; which = i + 1; } }
    ConvDesc d;
    switch (which) {
      case 0: d = {win, INC, 0, 1024, 2048, (bf16_t*)(ws + O_WG), 1024, nullptr}; break;
      case 1: d = {win, INC, 2048, 1024, 768, (bf16_t*)(ws + O_WP), 1024, nullptr}; break;
      case 2: d = {win, INC, 2816, 1024, 256, (bf16_t*)(ws + O_WP) + (size_t)768 * 1024, 1024, nullptr}; break;
      case 3: d = {win, INC, 3104, 1024, 1536, (bf16_t*)(ws + O_WP) + (size_t)1024 * 1024, 1024, nullptr}; break;
      case 4: d = {win, INC, 3072, 1024, 32, (bf16_t*)(ws + O_WP) + (size_t)2560 * 1024, 1024, nullptr}; break;
      case 5: d = {p.w_uq + (size_t)l * 768 * 768, 768, 0, 768, 768, (bf16_t*)(ws + O_WUQ), 768, p.g_qa + l * 768}; break;
      case 6: d = {p.w_ukv + (size_t)l * 256 * 1024, 1024, 0, 256, 1024, (bf16_t*)(ws + O_WUKV), 256, p.g_kva + l * 256}; break;
      case 7: d = {p.w_mla_o + (size_t)l * 512 * 1024, 1024, 0, 512, 1024, (bf16_t*)(ws + O_WMO), 512, nullptr}; break;
      case 8: d = {p.w_na_o + (size_t)l * 512 * 1024, 1024, 0, 512, 1024, (bf16_t*)(ws + O_WNO), 512, nullptr}; break;
      case 9: d = {p.w_out + (size_t)l * 1024 * 1024, 1024, 0, 1024, 1024, (bf16_t*)(ws + O_WOUT), 1024, nullptr}; break;
      case 10: d = {p.w_ff1 + (size_t)l * 1024 * 4096, 4096, 0, 1024, 4096, (bf16_t*)(ws + O_WFF1), 1024, nullptr}; break;
      default: d = {p.w_ff2 + (size_t)l * 4096 * 1024, 1024, 0, 4096, 1024, (bf16_t*)(ws + O_WFF2), 4096, nullptr}; break;
    }
    conv_tile(d, rem, smem);
  }
  {
    u32x4* z = (u32x4*)((bf16_t*)(ws + O_WP) + (size_t)2592 * 1024);
    const int n16 = 96 * 1024 * 2 / 16;
    for (int i = blockIdx.x * 256 + threadIdx.x; i < n16; i += gridDim.x * 256) z[i] = (u32x4){0u, 0u, 0u, 0u};
  }
}

DI void phase0(const Params& p, char* smem) {
  char* ws = p.ws;
  const int tid = otid();
  {
    const f32x4* sx = (const f32x4*)p.x; f32x4* dx = (f32x4*)p.out;
    const int nx = NBATCH * SEQ * DM / 4;
    for (int i = blockIdx.x * 256 + tid; i < nx; i += gridDim.x * 256) dx[i] = sx[i];
    const f32x4* sc = (const f32x4*)p.ctx; f32x4* dc = (f32x4*)(ws + O_XCTX);
    const int nc = NBATCH * CTXL * DM / 4;
    for (int i = blockIdx.x * 256 + tid; i < nc; i += gridDim.x * 256) dc[i] = sc[i];
  }
  if (blockIdx.x == gridDim.x - 1) {
    float* tab = (float*)(ws + O_TAB);
    for (int i = tid; i < 512; i += 256) {
      const int pos = i >> 3, f = i & 7;
      const float inv = powf(10000.f, -(float)f / 8.f);
      const float ang = (float)pos * inv;
      tab[i * 2] = cosf(ang); tab[i * 2 + 1] = sinf(ang);
    }
  }
  float* sc = (float*)smem;
  float* red = (float*)(smem + 36864);
  float* mod = (float*)(ws + O_MOD);
  for (int it = blockIdx.x; it < NLAYER * 96; it += gridDim.x) {
    const int l = it / 96, cgp = it % 96;
    for (int idx = tid; idx < 9 * 1024; idx += 256) {
      const int r = idx >> 10, k = idx & 1023;
      const float v = (r < 8) ? p.c[r * 1024 + k] : p.c_ctx[k];
      sc[idx] = v / (1.f + expf(-v));
    }
    __syncthreads();
    const int w = tid >> 6, lane = tid & 63, col = cgp * 64 + lane;
    float a[9];
#pragma unroll
    for (int r = 0; r < 9; ++r) a[r] = 0.f;
    const float* wp = p.w_ada + (size_t)l * 1024 * 6144 + col;
#pragma unroll 4
    for (int k = w * 256; k < w * 256 + 256; ++k) {
      const float wv = wp[(size_t)k * 6144];
#pragma unroll
      for (int r = 0; r < 9; ++r) a[r] += sc[r * 1024 + k] * wv;
    }
#pragma unroll
    for (int r = 0; r < 9; ++r) red[(w * 9 + r) * 64 + lane] = a[r];
    __syncthreads();
    for (int idx = tid; idx < 9 * 64; idx += 256) {
      const int r = idx >> 6, ln = idx & 63;
      const float s = red[(0 * 9 + r) * 64 + ln] + red[(1 * 9 + r) * 64 + ln] + red[(2 * 9 + r) * 64 + ln] + red[(3 * 9 + r) * 64 + ln];
      mod[(size_t)(l * 9 + r) * 6144 + cgp * 64 + ln] = s + p.b_ada[l * 6144 + cgp * 64 + ln];
    }
    __syncthreads();
  }
}

DI void phase_norm(const Params& p, int l, const float* g, int shift_idx, bool skip_ctx) {
  const int tid = otid(), lane = tid & 63, w = tid >> 6;
  const float* mod = (const float*)(p.ws + O_MOD) + (size_t)l * 9 * 6144;
  bf16_t* hb = (bf16_t*)(p.ws + O_HB);
  for (int row = blockIdx.x * 4 + w; row < TT; row += gridDim.x * 4) {
    const int b = row / TPB, t = row - b * TPB;
    if (skip_ctx && t < CTXL) continue;
    const float* xr = xrow_ptr(p, row);
    f32x4 v[4];
    float ss = 0.f;
#pragma unroll
    for (int i = 0; i < 4; ++i) { v[i] = *(const f32x4*)(xr + lane * 4 + i * 256); ss += v[i][0] * v[i][0] + v[i][1] * v[i][1] + v[i][2] * v[i][2] + v[i][3] * v[i][3]; }
    ss = wave_sum(ss);
    const float rs = rsqrtf(ss * (1.f / 1024.f) + EPS);
    const float* mr = mod + (size_t)(t < CTXL ? 8 : b) * 6144 + shift_idx * 1024;
#pragma unroll
    for (int i = 0; i < 4; ++i) {
      const int col = lane * 4 + i * 256;
      const f32x4 gg = *(const f32x4*)(g + col), sh = *(const f32x4*)(mr + col), scl = *(const f32x4*)(mr + 1024 + col);
      f32x4 y = (v[i] * rs) * gg;
      y = y * (scl + 1.f) + sh;
      u32x2 pk; pk.x = cvt_pk_bf16(y[0], y[1]); pk.y = cvt_pk_bf16(y[2], y[3]);
      *(u32x2*)(hb + (size_t)row * 1024 + col) = pk;
    }
  }
}

DI void rowstats_item(const Params& p, int item) {
  const int tid = otid(), lane = tid & 63, w = tid >> 6;
  const bf16_t* pb = (const bf16_t*)(p.ws + O_PB);
  float* st = (float*)(p.ws + O_STAT);
#pragma unroll 1
  for (int i = 0; i < 4; ++i) {
    const int row = item * 16 + w * 4 + i;
    const bf16_t* pr = pb + (size_t)row * PBW;
    float sq = 0.f, sk = 0.f;
    {
      u32x4 u = *(const u32x4*)(pr + lane * 8);
#pragma unroll
      for (int j = 0; j < 4; ++j) { float a = bflo(u[j]), b2 = bfhi(u[j]); sq += a * a + b2 * b2; }
    }
    if (lane < 32) {
      u32x4 u = *(const u32x4*)(pr + 512 + lane * 8);
#pragma unroll
      for (int j = 0; j < 4; ++j) { float a = bflo(u[j]), b2 = bfhi(u[j]); sq += a * a + b2 * b2; }
      u32x4 u2 = *(const u32x4*)(pr + 768 + lane * 8);
#pragma unroll
      for (int j = 0; j < 4; ++j) { float a = bflo(u2[j]), b2 = bfhi(u2[j]); sk += a * a + b2 * b2; }
    }
    sq = wave_sum(sq); sk = wave_sum(sk);
    if (lane == 0) { st[row * 2] = rsqrtf(sq * (1.f / 768.f) + EPS); st[row * 2 + 1] = rsqrtf(sk * (1.f / 256.f) + EPS); }
  }
}

DI void rope8(float (&x1)[8], float (&x2)[8], const float* tabrow) {
#pragma unroll
  for (int i = 0; i < 8; ++i) {
    const float c = tabrow[i * 2], s = tabrow[i * 2 + 1];
    const float a = x1[i], b = x2[i];
    x1[i] = a * c - b * s; x2[i] = a * s + b * c;
  }
}
DI void unpack8(const u32x4& u, float (&f)[8]) {
#pragma unroll
  for (int j = 0; j < 4; ++j) { f[2 * j] = bflo(u[j]); f[2 * j + 1] = bfhi(u[j]); }
}
DI u32x4 pack8(const float (&f)[8]) {
  u32x4 u;
#pragma unroll
  for (int j = 0; j < 4; ++j) u[j] = cvt_pk_bf16(f[2 * j], f[2 * j + 1]);
  return u;
}
DI float sumsq8(const u32x4& u) {
  float s = 0.f;
#pragma unroll
  for (int j = 0; j < 4; ++j) { float a = bflo(u[j]), b = bfhi(u[j]); s += a * a + b * b; }
  return s;
}
DI void finalize_wave_item(const Params& p, int l, int wi) {
  char* ws = p.ws;
  const int lane = otid() & 63;
  const int part = wi % 3, rest = wi / 3, h = rest & 7, g = rest >> 3;
  const int row = g * 64 + lane;
  const int b = g / 36, t = (g % 36) * 64 + lane;
  const bool is_ctx = t < CTXL;
  const float* tab = (const float*)(ws + O_TAB);
  const int pos = is_ctx ? 0 : t - CTXL;
  const float* tabr = tab + (pos >> 6) * 16;
  const float* tabc = tab + (pos & 63) * 16;
  const bf16_t* pb = (const bf16_t*)(ws + O_PB) + (size_t)row * PBW;
  const bf16_t* qk = (const bf16_t*)(ws + O_QK2) + (size_t)row * QKW;
  const float* st = (const float*)(ws + O_STAT) + row * 2;
  if (part == 0) {
    const bf16_t* src = qk + h * 96;
    u32x4 v[12];
    float ss = 0.f;
#pragma unroll
    for (int i = 0; i < 12; ++i) { v[i] = *(const u32x4*)(src + i * 8); ss += sumsq8(v[i]); }
    const float sq = st[0];
    const float sc = sq * rsqrtf(sq * sq * ss * (1.f / 96.f) + EPS);
    const float* gq = p.g_mla_q + l * 96;
    bf16_t* dst = (bf16_t*)(ws + O_MQ) + (size_t)row * 768 + h * 96;
#pragma unroll
    for (int i = 0; i < 8; ++i) {
      float f[8]; unpack8(v[i], f);
#pragma unroll
      for (int j = 0; j < 8; ++j) f[j] = f[j] * sc * gq[i * 8 + j];
      *(u32x4*)(dst + i * 8) = pack8(f);
    }
    float r0[8], r1[8], r2[8], r3[8];
    unpack8(v[8], r0); unpack8(v[9], r1); unpack8(v[10], r2); unpack8(v[11], r3);
#pragma unroll
    for (int j = 0; j < 8; ++j) { r0[j] *= sc * gq[64 + j]; r1[j] *= sc * gq[72 + j]; r2[j] *= sc * gq[80 + j]; r3[j] *= sc * gq[88 + j]; }
    if (!is_ctx) { rope8(r0, r1, tabr); rope8(r2, r3, tabc); }
    *(u32x4*)(dst + 64) = pack8(r0); *(u32x4*)(dst + 72) = pack8(r1); *(u32x4*)(dst + 80) = pack8(r2); *(u32x4*)(dst + 88) = pack8(r3);
  } else if (part == 1) {
    const bf16_t* src = qk + 768 + h * 128;
    const bf16_t* krp = pb + 2560;
    const float skv = st[1];
    u32x4 kn[8], kr[4];
    float ss = 0.f, sr = 0.f;
#pragma unroll
    for (int i = 0; i < 8; ++i) { kn[i] = *(const u32x4*)(src + i * 8); ss += sumsq8(kn[i]); }
#pragma unroll
    for (int i = 0; i < 4; ++i) { kr[i] = *(const u32x4*)(krp + i * 8); sr += sumsq8(kr[i]); }
    const float rs = rsqrtf((skv * skv * ss + sr) * (1.f / 96.f) + EPS);
    const float* gk = p.g_mla_k + l * 96;
    bf16_t* dst = (bf16_t*)(ws + O_MK) + (size_t)row * 768 + h * 96;
    const float scn = skv * rs;
#pragma unroll
    for (int i = 0; i < 8; ++i) {
      float f[8]; unpack8(kn[i], f);
#pragma unroll
      for (int j = 0; j < 8; ++j) f[j] = f[j] * scn * gk[i * 8 + j];
      *(u32x4*)(dst + i * 8) = pack8(f);
    }
    float r0[8], r1[8], r2[8], r3[8];
    unpack8(kr[0], r0); unpack8(kr[1], r1); unpack8(kr[2], r2); unpack8(kr[3], r3);
#pragma unroll
    for (int j = 0; j < 8; ++j) { r0[j] *= rs * gk[64 + j]; r1[j] *= rs * gk[72 + j]; r2[j] *= rs * gk[80 + j]; r3[j] *= rs * gk[88 + j]; }
    if (!is_ctx) { rope8(r0, r1, tabr); rope8(r2, r3, tabc); }
    *(u32x4*)(dst + 64) = pack8(r0); *(u32x4*)(dst + 72) = pack8(r1); *(u32x4*)(dst + 80) = pack8(r2); *(u32x4*)(dst + 88) = pack8(r3);
    bf16_t* vt = (bf16_t*)(ws + O_MVT) + ((size_t)(b * 8 + h) * 64) * TPB + t;
#pragma unroll
    for (int i = 0; i < 8; ++i) {
      const u32x4 u = *(const u32x4*)(src + 64 + i * 8);
      float f[8]; unpack8(u, f);
#pragma unroll
      for (int j = 0; j < 8; ++j) vt[(size_t)(i * 8 + j) * TPB] = f2bf(f[j] * skv);
    }
  } else {
    const bf16_t* sq_ = pb + 1024 + h * 64;
    const bf16_t* sk_ = pb + 1536 + h * 64;
    const bf16_t* sv_ = pb + 2048 + h * 64;
    {
      u32x4 v[8]; float ss = 0.f;
#pragma unroll
      for (int i = 0; i < 8; ++i) { v[i] = *(const u32x4*)(sq_ + i * 8); ss += sumsq8(v[i]); }
      const float rs = rsqrtf(ss * (1.f / 64.f) + EPS);
      const float* gq = p.g_na_q + l * 64;
      bf16_t* dst = (bf16_t*)(ws + O_NQ) + (size_t)row * 512 + h * 64;
#pragma unroll
      for (int i = 0; i < 8; ++i) {
        float f[8]; unpack8(v[i], f);
#pragma unroll
        for (int j = 0; j < 8; ++j) f[j] = f[j] * rs * gq[i * 8 + j];
        *(u32x4*)(dst + i * 8) = pack8(f);
      }
    }
    {
      u32x4 v[8]; float ss = 0.f;
#pragma unroll
      for (int i = 0; i < 8; ++i) { v[i] = *(const u32x4*)(sk_ + i * 8); ss += sumsq8(v[i]); }
      const float rs = rsqrtf(ss * (1.f / 64.f) + EPS);
      const float* gk = p.g_na_k + l * 64;
      bf16_t* dst = (bf16_t*)(ws + O_NK) + (size_t)row * 512 + h * 64;
#pragma unroll
      for (int i = 0; i < 8; ++i) {
        float f[8]; unpack8(v[i], f);
#pragma unroll
        for (int j = 0; j < 8; ++j) f[j] = f[j] * rs * gk[i * 8 + j];
        *(u32x4*)(dst + i * 8) = pack8(f);
      }
    }
    bf16_t* vt = (bf16_t*)(ws + O_NVT) + ((size_t)(b * 8 + h) * 64) * TPB + t;
    const bf16_t* svb = sv_;
#pragma unroll
    for (int i = 0; i < 8; ++i) {
      const u32x4 u = *(const u32x4*)(svb + i * 8);
      vt[(size_t)(i * 8 + 0) * TPB] = (bf16_t)(u[0] & 0xffffu); vt[(size_t)(i * 8 + 1) * TPB] = (bf16_t)(u[0] >> 16);
      vt[(size_t)(i * 8 + 2) * TPB] = (bf16_t)(u[1] & 0xffffu); vt[(size_t)(i * 8 + 3) * TPB] = (bf16_t)(u[1] >> 16);
      vt[(size_t)(i * 8 + 4) * TPB] = (bf16_t)(u[2] & 0xffffu); vt[(size_t)(i * 8 + 5) * TPB] = (bf16_t)(u[2] >> 16);
      vt[(size_t)(i * 8 + 6) * TPB] = (bf16_t)(u[3] & 0xffffu); vt[(size_t)(i * 8 + 7) * TPB] = (bf16_t)(u[3] >> 16);
    }
  }
}

template <int DQK, bool NA>
DI void attn_item(const bf16_t* __restrict__ Qp, int ldq, const bf16_t* __restrict__ Kp, int ldk, const bf16_t* __restrict__ Vp,
                  int nkt, int koff, float c1, int r0, int rs, const float* __restrict__ rpb_g, bf16_t* __restrict__ Op, char* smem) {
  constexpr int KSTR = DQK * 2 + 32, KBYTES = 64 * KSTR, VBYTES = 64 * 144, STG = KBYTES + VBYTES;
  constexpr int CPK = DQK / 8, NKC = CPK / 4, NDS = DQK / 32;
  const int tid = otid(), lane = tid & 63, w = tid >> 6, fr = lane & 15, fq = lane >> 4;
  float* rpbl = (float*)(smem + 2 * STG);
  if (NA) { for (int i = tid; i < 465; i += 256) rpbl[i] = rpb_g[i] * LOG2E; }
  bf16x8 qf[2][NDS];
#pragma unroll
  for (int qt = 0; qt < 2; ++qt)
#pragma unroll
    for (int ds = 0; ds < NDS; ++ds) qf[qt][ds] = *(const bf16x8*)(Qp + (size_t)(w * 32 + qt * 16 + fr) * ldq + ds * 32 + fq * 8);
  u32x4 rk[NKC], rv[2];
  int kkey[NKC], kcc[NKC];
#pragma unroll
  for (int i = 0; i < NKC; ++i) { const int c = tid + i * 256; kkey[i] = c / CPK; kcc[i] = c - kkey[i] * CPK; }
  const int vdv = tid >> 3, vcc = tid & 7;
  {
#pragma unroll
    for (int i = 0; i < NKC; ++i) rk[i] = *(const u32x4*)(Kp + (size_t)kkey[i] * ldk + kcc[i] * 8);
#pragma unroll
    for (int i = 0; i < 2; ++i) rv[i] = *(const u32x4*)(Vp + (size_t)(vdv + i * 32) * TPB + vcc * 8);
#pragma unroll
    for (int i = 0; i < NKC; ++i) *(u32x4*)(smem + kkey[i] * KSTR + kcc[i] * 16) = rk[i];
#pragma unroll
    for (int i = 0; i < 2; ++i) *(u32x4*)(smem + KBYTES + (vdv + i * 32) * 144 + vcc * 16) = rv[i];
  }
  __syncthreads();
  f32x4 o[4][2];
  float mrun[2], lrun[2];
#pragma unroll
  for (int qt = 0; qt < 2; ++qt) {
    mrun[qt] = -1e30f; lrun[qt] = 0.f;
#pragma unroll
    for (int d = 0; d < 4; ++d) o[d][qt] = (f32x4){0.f, 0.f, 0.f, 0.f};
  }
  for (int it = 0; it < nkt; ++it) {
    const int cur = it & 1;
    const bool more = it + 1 < nkt;
    if (more) {
      const int kb = (it + 1) * 64 + ((it + 1) >= 4 ? koff : 0);
#pragma unroll
      for (int i = 0; i < NKC; ++i) rk[i] = *(const u32x4*)(Kp + (size_t)(kb + kkey[i]) * ldk + kcc[i] * 8);
#pragma unroll
      for (int i = 0; i < 2; ++i) rv[i] = *(const u32x4*)(Vp + (size_t)(vdv + i * 32) * TPB + kb + vcc * 8);
    }
    const char* ks = smem + cur * STG;
    const char* vs = ks + KBYTES;
    f32x4 s[4][2];
#pragma unroll
    for (int kt = 0; kt < 4; ++kt) { s[kt][0] = (f32x4){0.f, 0.f, 0.f, 0.f}; s[kt][1] = (f32x4){0.f, 0.f, 0.f, 0.f}; }
#pragma unroll
    for (int ds = 0; ds < NDS; ++ds) {
      bf16x8 kf[4];
#pragma unroll
      for (int kt = 0; kt < 4; ++kt) kf[kt] = *(const bf16x8*)(ks + (kt * 16 + fr) * KSTR + ds * 64 + fq * 16);
#pragma unroll
      for (int kt = 0; kt < 4; ++kt) {
        s[kt][0] = __builtin_amdgcn_mfma_f32_16x16x32_bf16(kf[kt], qf[0][ds], s[kt][0], 0, 0, 0);
        s[kt][1] = __builtin_amdgcn_mfma_f32_16x16x32_bf16(kf[kt], qf[1][ds], s[kt][1], 0, 0, 0);
      }
    }
#pragma unroll
    for (int qt = 0; qt < 2; ++qt) {
      float mx = -1e30f;
      if (NA && it >= 4) {
        const int kr = rs + (it - 4);
        const int ql = w * 32 + qt * 16 + fr, qr = r0 + (ql >> 6), qc = ql & 63;
        const int rst = min(max(qr - 4, 0), 24);
        const bool rowok = (kr >= rst) && (kr < rst + 8);
        const int cst = min(max(qc - 8, 0), 48);
        const int base = (kr - qr + 7) * 31 + 15 - qc;
#pragma unroll
        for (int kt = 0; kt < 4; ++kt)
#pragma unroll
          for (int j = 0; j < 4; ++j) {
            const int kc = kt * 16 + fq * 4 + j;
            const bool ok = rowok && (kc >= cst) && (kc < cst + 16);
            const float bias = rpbl[ok ? base + kc : 0];
            const float tv = ok ? s[kt][qt][j] * c1 + bias : -1e30f;
            s[kt][qt][j] = tv; mx = fmaxf(mx, tv);
          }
      } else {
#pragma unroll
        for (int kt = 0; kt < 4; ++kt)
#pragma unroll
          for (int j = 0; j < 4; ++j) { const float tv = s[kt][qt][j] * c1; s[kt][qt][j] = tv; mx = fmaxf(mx, tv); }
      }
      mx = fmaxf(mx, __shfl_xor(mx, 16));
      mx = fmaxf(mx, __shfl_xor(mx, 32));
      const float mnew = fmaxf(mrun[qt], mx);
      const float alpha = __builtin_amdgcn_exp2f(mrun[qt] - mnew);
      mrun[qt] = mnew;
      float sum = 0.f;
#pragma unroll
      for (int kt = 0; kt < 4; ++kt)
#pragma unroll
        for (int j = 0; j < 4; ++j) { const float pv = __builtin_amdgcn_exp2f(s[kt][qt][j] - mnew); s[kt][qt][j] = pv; sum += pv; }
      lrun[qt] = lrun[qt] * alpha + sum;
#pragma unroll
      for (int d = 0; d < 4; ++d) o[d][qt] = o[d][qt] * alpha;
    }
#pragma unroll
    for (int k2 = 0; k2 < 2; ++k2) {
      bf16x8 pf[2];
#pragma unroll
      for (int qt = 0; qt < 2; ++qt) {
        u32x4 u;
        u[0] = cvt_pk_bf16(s[2 * k2][qt][0], s[2 * k2][qt][1]); u[1] = cvt_pk_bf16(s[2 * k2][qt][2], s[2 * k2][qt][3]);
        u[2] = cvt_pk_bf16(s[2 * k2 + 1][qt][0], s[2 * k2 + 1][qt][1]); u[3] = cvt_pk_bf16(s[2 * k2 + 1][qt][2], s[2 * k2 + 1][qt][3]);
        pf[qt] = __builtin_bit_cast(bf16x8, u);
      }
#pragma unroll
      for (int d = 0; d < 4; ++d) {
        const char* vp = vs + (d * 16 + fr) * 144 + k2 * 64 + fq * 8;
        const u32x2 lo = *(const u32x2*)vp, hi = *(const u32x2*)(vp + 32);
        u32x4 u; u[0] = lo.x; u[1] = lo.y; u[2] = hi.x; u[3] = hi.y;
        const bf16x8 vf = __builtin_bit_cast(bf16x8, u);
        o[d][0] = __builtin_amdgcn_mfma_f32_16x16x32_bf16(vf, pf[0], o[d][0], 0, 0, 0);
        o[d][1] = __builtin_amdgcn_mfma_f32_16x16x32_bf16(vf, pf[1], o[d][1], 0, 0, 0);
      }
    }
    if (more) {
      char* nx = smem + (cur ^ 1) * STG;
#pragma unroll
      for (int i = 0; i < NKC; ++i) *(u32x4*)(nx + kkey[i] * KSTR + kcc[i] * 16) = rk[i];
#pragma unroll
      for (int i = 0; i < 2; ++i) *(u32x4*)(nx + KBYTES + (vdv + i * 32) * 144 + vcc * 16) = rv[i];
    }
    __syncthreads();
  }
#pragma unroll
  for (int qt = 0; qt < 2; ++qt) {
    float lt = lrun[qt];
    lt += __shfl_xor(lt, 16);
    lt += __shfl_xor(lt, 32);
    const float inv = 1.f / lt;
#pragma unroll
    for (int d = 0; d < 4; ++d) {
      u32x2 pk; pk.x = cvt_pk_bf16(o[d][qt][0] * inv, o[d][qt][1] * inv); pk.y = cvt_pk_bf16(o[d][qt][2] * inv, o[d][qt][3] * inv);
      *(u32x2*)(Op + (size_t)(w * 32 + qt * 16 + fr) * 512 + d * 16 + fq * 4) = pk;
    }
  }
}

DI void phase_attn(const Params& p, int l, bool last, char* smem) {
  char* ws = p.ws;
  const bf16_t* mq = (const bf16_t*)(ws + O_MQ); const bf16_t* mk = (const bf16_t*)(ws + O_MK); const bf16_t* mvt = (const bf16_t*)(ws + O_MVT);
  const bf16_t* nq = (const bf16_t*)(ws + O_NQ); const bf16_t* nk = (const bf16_t*)(ws + O_NK); const bf16_t* nvt = (const bf16_t*)(ws + O_NVT);
  bf16_t* ymla = (bf16_t*)(ws + O_YMLA); bf16_t* yna = (bf16_t*)(ws + O_YNA);
  const float c_mla = LOG2E * 0.10206207261596575f;
  const float c_na = LOG2E * 0.125f;
  const int n_items = last ? 2048 : 2048 + 256;
  for (int item = blockIdx.x; item < n_items; item += gridDim.x) {
    if (item < 2048) {
      const int kind = item >> 10, it2 = item & 1023;
      const int xx = it2 & 7, yy = it2 >> 3;
      const int bh = xx + 8 * (yy >> 4), qt = yy & 15;
      const int b = bh >> 3, h = bh & 7;
      const int q0 = b * TPB + CTXL + qt * 128;
      if (kind == 0) {
        attn_item<96, false>(mq + (size_t)q0 * 768 + h * 96, 768, mk + (size_t)b * TPB * 768 + h * 96, 768, mvt + (size_t)bh * 64 * TPB,
                             36, 0, c_mla, 0, 0, nullptr, ymla + (size_t)q0 * 512 + h * 64, smem);
      } else {
        const int r0 = qt * 2;
        const int rs = min(max(r0 - 4, 0), 24);
        const int re = min(max(r0 + 1 - 4, 0), 24) + 8;
        attn_item<64, true>(nq + (size_t)q0 * 512 + h * 64, 512, nk + (size_t)b * TPB * 512 + h * 64, 512, nvt + (size_t)bh * 64 * TPB,
                            4 + (re - rs), rs * 64, c_na, r0, rs, p.rpb + ((size_t)l * 8 + h) * 465, yna + (size_t)q0 * 512 + h * 64, smem);
      }
    } else {
      const int it2 = item - 2048;
      const int kind = it2 >> 7, i3 = it2 & 127;
      const int bh = i3 >> 1, qt = i3 & 1;
      const int b = bh >> 3, h = bh & 7;
      const int q0 = b * TPB + qt * 128;
      if (kind == 0)
        attn_item<96, false>(mq + (size_t)q0 * 768 + h * 96, 768, mk + (size_t)b * TPB * 768 + h * 96, 768, mvt + (size_t)bh * 64 * TPB,
                             4, 0, c_mla, 0, 0, nullptr, ymla + (size_t)q0 * 512 + h * 64, smem);
      else
        attn_item<64, false>(nq + (size_t)q0 * 512 + h * 64, 512, nk + (size_t)b * TPB * 512 + h * 64, 512, nvt + (size_t)bh * 64 * TPB,
                             4, 0, c_na, 0, 0, nullptr, yna + (size_t)q0 * 512 + h * 64, smem);
    }
  }
}

DI void gsync(cg::grid_group& grid) { __threadfence(); grid.sync(); }
__global__ void __launch_bounds__(256, 2) fwd_megakernel(Params p) {
  __shared__ __attribute__((aligned(16))) char smem[65536];
  cg::grid_group grid = cg::this_grid();
  char* ws = p.ws;
  const int G = gridDim.x;

#ifndef NO_P0
  phase0(p, smem);
  convert_weights(p, 0, smem);
#endif
  gsync(grid);

  for (int l = 0; l < NLAYER; ++l) {
    const bool last = (l == NLAYER - 1);
    const float* mod = (const float*)(ws + O_MOD) + (size_t)l * 9 * 6144;
    bf16_t* hb = (bf16_t*)(ws + O_HB);
    bf16_t* pb = (bf16_t*)(ws + O_PB);
    bf16_t* qk2 = (bf16_t*)(ws + O_QK2);

#ifndef NO_P0
    if (l > 0) convert_weights(p, l, smem);
#endif
#ifndef NO_A
    phase_norm(p, l, p.g_attn + l * 1024, 0, false);
#endif
    gsync(grid);

#ifndef NO_B
    for (int t = blockIdx.x; t < NRT * 21; t += G) {
      const int rt = t % NRT, ct = t / NRT;
      f32x4 acc[4][4]; acc_zero(acc);
      gemm_main(hb + (size_t)rt * 128 * 1024, 1024, (const bf16_t*)(ws + O_WP) + (size_t)ct * 128 * 1024, 1024, 1024, smem, acc);
      store_bf16_tile<0>(acc, pb + (size_t)rt * 128 * PBW + ct * 128, PBW);
    }
    gsync(grid);

#endif
#ifndef NO_C1
    for (int t = blockIdx.x; t < NRT * 14 + TT / 16; t += G) {
      if (t < NRT * 6) {
        const int rt = t % NRT, ct = t / NRT;
        f32x4 acc[4][4]; acc_zero(acc);
        gemm_main(pb + (size_t)rt * 128 * PBW, PBW, (const bf16_t*)(ws + O_WUQ) + (size_t)ct * 128 * 768, 768, 768, smem, acc);
        store_bf16_tile<0>(acc, qk2 + (size_t)rt * 128 * QKW + ct * 128, QKW);
      } else if (t < NRT * 14) {
        const int t2 = t - NRT * 6;
        const int rt = t2 % NRT, ct = t2 / NRT;
        f32x4 acc[4][4]; acc_zero(acc);
        gemm_main(pb + (size_t)rt * 128 * PBW + 768, PBW, (const bf16_t*)(ws + O_WUKV) + (size_t)ct * 128 * 256, 256, 256, smem, acc);
        store_bf16_tile<0>(acc, qk2 + (size_t)rt * 128 * QKW + 768 + ct * 128, QKW);
      } else {
        rowstats_item(p, t - NRT * 14);
      }
    }
    gsync(grid);

#endif
#ifndef NO_C2
    {
      const int w = otid() >> 6;
      for (int wi = blockIdx.x * 4 + w; wi < 288 * 8 * 3; wi += G * 4) finalize_wave_item(p, l, wi);
    }
    gsync(grid);

#endif
#ifndef NO_D
    phase_attn(p, l, last, smem);
    gsync(grid);

#endif
#ifndef NO_E
    for (int t = blockIdx.x; t < NRT * 16; t += G) {
      const int rt = t % NRT, ct = t / NRT;
      if (last && (rt % 18) < 2) continue;
      f32x4 acc[4][2];
      u32x2 gte[4][2], yv[4][2];
      const bf16_t* hA = hb + (size_t)rt * 128 * 1024;
      acc_zero(acc);
      gemm_main(hA, 1024, (const bf16_t*)(ws + O_WG) + (size_t)ct * 64 * 1024, 1024, 1024, smem, acc);
#pragma unroll
      for (int m = 0; m < 4; ++m)
#pragma unroll
        for (int n = 0; n < 2; ++n) {
          float sg[4];
#pragma unroll
          for (int j = 0; j < 4; ++j) sg[j] = 1.f / (1.f + __expf(-acc[m][n][j]));
          gte[m][n].x = cvt_pk_bf16(sg[0], sg[1]); gte[m][n].y = cvt_pk_bf16(sg[2], sg[3]);
        }
      acc_zero(acc);
      gemm_main((const bf16_t*)(ws + O_YMLA) + (size_t)rt * 128 * 512, 512, (const bf16_t*)(ws + O_WMO) + (size_t)ct * 64 * 512, 512, 512, smem, acc);
#pragma unroll
      for (int m = 0; m < 4; ++m)
#pragma unroll
        for (int n = 0; n < 2; ++n) {
          yv[m][n].x = cvt_pk_bf16(bflo(gte[m][n].x) * acc[m][n][0], bfhi(gte[m][n].x) * acc[m][n][1]);
          yv[m][n].y = cvt_pk_bf16(bflo(gte[m][n].y) * acc[m][n][2], bfhi(gte[m][n].y) * acc[m][n][3]);
        }
      acc_zero(acc);
      gemm_main(hA, 1024, (const bf16_t*)(ws + O_WG) + (size_t)(1024 + ct * 64) * 1024, 1024, 1024, smem, acc);
#pragma unroll
      for (int m = 0; m < 4; ++m)
#pragma unroll
        for (int n = 0; n < 2; ++n) {
          float sg[4];
#pragma unroll
          for (int j = 0; j < 4; ++j) sg[j] = 1.f / (1.f + __expf(-acc[m][n][j]));
          gte[m][n].x = cvt_pk_bf16(sg[0], sg[1]); gte[m][n].y = cvt_pk_bf16(sg[2], sg[3]);
        }
      acc_zero(acc);
      gemm_main((const bf16_t*)(ws + O_YNA) + (size_t)rt * 128 * 512, 512, (const bf16_t*)(ws + O_WNO) + (size_t)ct * 64 * 512, 512, 512, smem, acc);
#pragma unroll
      for (int m = 0; m < 4; ++m)
#pragma unroll
        for (int n = 0; n < 2; ++n) {
          acc[m][n][0] = bflo(yv[m][n].x) + bflo(gte[m][n].x) * acc[m][n][0]; acc[m][n][1] = bfhi(yv[m][n].x) + bfhi(gte[m][n].x) * acc[m][n][1];
          acc[m][n][2] = bflo(yv[m][n].y) + bflo(gte[m][n].y) * acc[m][n][2]; acc[m][n][3] = bfhi(yv[m][n].y) + bfhi(gte[m][n].y) * acc[m][n][3];
        }
      store_bf16_tile<0>(acc, (bf16_t*)(ws + O_Y) + (size_t)rt * 128 * 1024 + ct * 64, 1024);
    }
    gsync(grid);

#endif
#ifndef NO_F
    for (int t = blockIdx.x; t < NRT * 8; t += G) {
      const int rt = t % NRT, ct = t / NRT;
      if (last && (rt % 18) < 2) continue;
      f32x4 acc[4][4]; acc_zero(acc);
      gemm_main((const bf16_t*)(ws + O_Y) + (size_t)rt * 128 * 1024, 1024, (const bf16_t*)(ws + O_WOUT) + (size_t)ct * 128 * 1024, 1024, 1024, smem, acc);
      residual_tile(acc, xrow_ptr(p, rt * 128) + ct * 128, mod + (size_t)modrow_of(rt * 128) * 6144 + 2 * 1024 + ct * 128);
    }
    gsync(grid);

#endif
#ifndef NO_GHI
    phase_norm(p, l, p.g_mlp + l * 1024, 3, last);
    gsync(grid);

    for (int t = blockIdx.x; t < NRT * 32; t += G) {
      const int rt = t % NRT, ct = t / NRT;
      if (last && (rt % 18) < 2) continue;
      f32x4 acc[4][4]; acc_zero(acc);
      gemm_main(hb + (size_t)rt * 128 * 1024, 1024, (const bf16_t*)(ws + O_WFF1) + (size_t)ct * 128 * 1024, 1024, 1024, smem, acc);
      store_bf16_tile<1>(acc, (bf16_t*)(ws + O_HID) + (size_t)rt * 128 * 4096 + ct * 128, 4096);
    }
    gsync(grid);

    for (int t = blockIdx.x; t < NRT * 8; t += G) {
      const int rt = t % NRT, ct = t / NRT;
      if (last && (rt % 18) < 2) continue;
      f32x4 acc[4][4]; acc_zero(acc);
      gemm_main((const bf16_t*)(ws + O_HID) + (size_t)rt * 128 * 4096, 4096, (const bf16_t*)(ws + O_WFF2) + (size_t)ct * 128 * 4096, 4096, 4096, smem, acc);
      residual_tile(acc, xrow_ptr(p, rt * 128) + ct * 128, mod + (size_t)modrow_of(rt * 128) * 6144 + 5 * 1024 + ct * 128);
    }
#endif
    if (!last) gsync(grid);
  }
}

extern "C" void kernel_launch(void* const* d_in, const int* in_sizes, int n_in, void* d_out, int out_size, void* d_ws, size_t ws_size, hipStream_t stream) {
  static int grid_blocks = 0;
  if (!grid_blocks) {
    int dev = 0, cus = 0, per_cu = 0;
    hipGetDevice(&dev);
    hipDeviceGetAttribute(&cus, hipDeviceAttributeMultiprocessorCount, dev);
    hipOccupancyMaxActiveBlocksPerMultiprocessor(&per_cu, fwd_megakernel, 256, 0);
    if (per_cu > 2) per_cu = 2;
    if (per_cu < 1) per_cu = 1;
    grid_blocks = cus * per_cu;
  }
  if (ws_size < O_END) { fprintf(stderr, "workspace too small: %zu < %zu\n", ws_size, (size_t)O_END); return; }
  Params p{};
  const float** f = (const float**)&p;
  for (int i = 0; i < 23; ++i) f[i] = (const float*)d_in[i];
  p.out = (float*)d_out;
  p.ws = (char*)d_ws;
  void* args[] = {&p};
  hipError_t e = hipLaunchCooperativeKernel((void*)fwd_megakernel, dim3(grid_blocks), dim3(256), args, 0, stream);
  if (e != hipSuccess) fprintf(stderr, "cooperative launch failed: %s (grid %d)\n", hipGetErrorString(e), grid_blocks);
}
```

```cpp
#include <hip/hip_runtime.h>
#include <hip/hip_cooperative_groups.h>
#include <cstdio>
namespace cg = cooperative_groups;

typedef unsigned short bf16_t;
typedef short bf16x8 __attribute__((ext_vector_type(8)));
typedef float f32x4 __attribute__((ext_vector_type(4)));
typedef unsigned u32x4 __attribute__((ext_vector_type(4)));
typedef unsigned u32x2 __attribute__((ext_vector_type(2)));
#define DI __device__ __forceinline__

constexpr int DM = 1024, NBATCH = 8, SEQ = 2048, CTXL = 256, TPB = 2304, TT = 18432, NLAYER = 4;
constexpr int NRT = TT / 256;
constexpr int NTHR = 512, NWAVE = 8;
constexpr int INC = 4640;
constexpr int PBW = 2816;
constexpr int HLD = 4160;
constexpr int QKW = 1792;
constexpr float EPS = 1e-6f;
constexpr float LOG2E = 1.4426950408889634f;

constexpr size_t al256(size_t x) { return (x + 255) & ~(size_t)255; }
constexpr size_t O_WG   = 0;
constexpr size_t O_WP   = O_WG   + (size_t)2048 * 1024 * 2;
constexpr size_t O_WUQ  = O_WP   + (size_t)PBW * 1024 * 2;
constexpr size_t O_WUKV = O_WUQ  + (size_t)768 * 768 * 2;
constexpr size_t O_WMO  = O_WUKV + (size_t)1024 * 256 * 2;
constexpr size_t O_WNO  = O_WMO  + (size_t)1024 * 512 * 2;
constexpr size_t O_WOUT = O_WNO  + (size_t)1024 * 512 * 2;
constexpr size_t O_WFF1 = O_WOUT + (size_t)1024 * 1024 * 2;
constexpr size_t O_WFF2 = O_WFF1 + (size_t)4096 * 1024 * 2;
constexpr size_t O_MOD  = O_WFF2 + (size_t)4096 * 1024 * 2;
constexpr size_t O_TAB  = al256(O_MOD + (size_t)4 * 9 * 6144 * 4);
constexpr size_t O_STAT = al256(O_TAB + 64 * 8 * 2 * 4);
constexpr size_t O_XCTX = al256(O_STAT + (size_t)TT * 2 * 4);
constexpr size_t O_HB   = al256(O_XCTX + (size_t)2048 * 1024 * 4);
constexpr size_t O_PB   = al256(O_HB + (size_t)TT * 1024 * 2);
constexpr size_t O_QK2  = O_PB + (size_t)TT * PBW * 2;
constexpr size_t O_R2   = al256(O_QK2 + (size_t)TT * QKW * 2);
constexpr size_t O_MQ   = O_R2;
constexpr size_t O_MK   = O_MQ + (size_t)TT * 768 * 2;
constexpr size_t O_MVT  = O_MK + (size_t)TT * 768 * 2;
constexpr size_t O_NQ   = O_MVT + (size_t)TT * 512 * 2;
constexpr size_t O_NK   = O_NQ + (size_t)TT * 512 * 2;
constexpr size_t O_NVT  = O_NK + (size_t)TT * 512 * 2;
constexpr size_t O_BAR  = al256(O_NVT + (size_t)TT * 512 * 2);
constexpr size_t O_CE    = O_BAR + 16384;
constexpr size_t O_GATEC = O_BAR + 32768;
constexpr size_t O_W2   = al256(O_GATEC + (size_t)2048 * 2048 * 2);
constexpr size_t W_SET  = O_MOD - O_WG;
constexpr size_t O_END  = O_W2 + W_SET;
DI size_t wset(int l) { return (l & 1) ? (O_W2 - O_WG) : (size_t)0; }
constexpr size_t O_YMLA = O_QK2;
constexpr size_t O_YNA  = O_QK2 + (size_t)TT * 512 * 2;
constexpr size_t O_Y    = O_MQ;
constexpr size_t O_HID  = O_PB;
constexpr size_t O_GATE = O_PB;

struct Params {
  const float *x, *c, *ctx, *c_ctx, *w_ada, *b_ada, *g_attn, *w_in, *g_qa, *w_uq, *g_kva, *w_ukv, *g_mla_q, *g_mla_k, *g_na_q, *g_na_k, *rpb,
      *w_mla_o, *w_na_o, *w_out, *g_mlp, *w_ff1, *w_ff2;
  float* out;
  char* ws;
};

typedef float f32x2_t __attribute__((ext_vector_type(2)));
typedef __bf16 bf16x2_t __attribute__((ext_vector_type(2)));
DI unsigned cvt_pk_bf16(float lo, float hi) { f32x2_t v = {lo, hi}; bf16x2_t b = __builtin_convertvector(v, bf16x2_t); return __builtin_bit_cast(unsigned, b); }
DI bf16_t f2bf(float x) { unsigned u = __float_as_uint(x); u += 0x7fffu + ((u >> 16) & 1u); return (bf16_t)(u >> 16); }
DI float bflo(unsigned u) { return __uint_as_float(u << 16); }
DI float bfhi(unsigned u) { return __uint_as_float(u & 0xffff0000u); }
DI int otid() { int t = threadIdx.x; asm volatile("" : "+v"(t)); return t; }
struct Params;
DI float wave_sum(float v) {
#pragma unroll
  for (int o = 32; o >= 1; o >>= 1) v += __shfl_xor(v, o);
  return v;
}
DI float* xrow_ptr(const Params& p, int urow) {
  const int b = urow / TPB, t = urow - b * TPB;
  return t < CTXL ? (float*)(p.ws + O_XCTX) + ((size_t)(b * CTXL + t)) * DM : p.out + ((size_t)(b * SEQ + t - CTXL)) * DM;
}
DI const float* xrow_src(const Params& p, int urow, bool from_input) {
  const int b = urow / TPB, t = urow - b * TPB;
  if (from_input) return t < CTXL ? p.ctx + ((size_t)(b * CTXL + t)) * DM : p.x + ((size_t)(b * SEQ + t - CTXL)) * DM;
  return t < CTXL ? (const float*)(p.ws + O_XCTX) + ((size_t)(b * CTXL + t)) * DM : p.out + ((size_t)(b * SEQ + t - CTXL)) * DM;
}
DI char* wsop(const Params& p) { char* w = p.ws; asm volatile("" : "+s"(w)); return w; }
DI int modrow_of(int urow) { const int b = urow / TPB, t = urow - b * TPB; return t < CTXL ? 8 : b; }

extern __shared__ __attribute__((aligned(16))) char smem[];
typedef f32x4 acc_t[2][2][4][2];
DI int lds_byte(int r, int c) { const int st = (r >> 4) * 2 + (c >> 5), rr = r & 15, cc = c & 31, ob = rr * 64 + cc * 2; return st * 1024 + (ob ^ (((ob >> 9) & 1) << 5)); }
DI int perm32(int rho) { const int n = rho >> 4, i = rho & 15; return 8 * (i >> 2) + 4 * n + (i & 3); }
DI void stage_rc(int b, int& R, int& C) { const int st = b / 1024, sb = b % 1024, swz = sb ^ (((sb >> 9) & 1) << 5); R = (st >> 1) * 16 + swz / 64; C = (st & 1) * 32 + (swz % 64) / 2; }

template <int lda, int ldb, int K, class Gen, class Epi>
DI void gemm_stream(Gen gen, Epi epi) {
  constexpr int HTB = 16384, nt = K / 64;
#define SA(b, h) (smem + ((b) * 2 + (h)) * HTB)
#define SB(b, h) (smem + (4 + (b) * 2 + (h)) * HTB)
#define STG_A(P, ptr) do { const bf16_t* _g = (ptr); \
    __builtin_amdgcn_global_load_lds((const unsigned*)(_g + oa0), (__attribute__((address_space(3))) unsigned*)((P) + tb0), 16, 0, 0); \
    __builtin_amdgcn_global_load_lds((const unsigned*)(_g + (size_t)64 * lda + oa0), (__attribute__((address_space(3))) unsigned*)((P) + tb1), 16, 0, 0); } while (0)
#define STG_B(P, ptr) do { const bf16_t* _g = (ptr); \
    __builtin_amdgcn_global_load_lds((const unsigned*)(_g + ob0), (__attribute__((address_space(3))) unsigned*)((P) + tb0), 16, 0, 0); \
    __builtin_amdgcn_global_load_lds((const unsigned*)(_g + (size_t)64 * ldb + ob0), (__attribute__((address_space(3))) unsigned*)((P) + tb1), 16, 0, 0); } while (0)
#define LDA(dst, b, h) _Pragma("unroll") for (int m = 0; m < 4; ++m) _Pragma("unroll") for (int k = 0; k < 2; ++k) \
    dst[m][k] = *reinterpret_cast<const bf16x8*>(SA(b, h) + lds_byte(wr * 64 + m * 16 + fr, k * 32 + fq * 8))
#define LDB(dst, b, h) _Pragma("unroll") for (int n = 0; n < 2; ++n) _Pragma("unroll") for (int k = 0; k < 2; ++k) \
    dst[n][k] = *reinterpret_cast<const bf16x8*>(SB(b, h) + lds_byte(wc * 32 + n * 16 + fr, k * 32 + fq * 8))
#define MMA(ai, bj, At_, Bt_) do { __builtin_amdgcn_s_setprio(1); \
    _Pragma("unroll") for (int m = 0; m < 4; ++m) _Pragma("unroll") for (int n = 0; n < 2; ++n) _Pragma("unroll") for (int k = 0; k < 2; ++k) \
      acc[ai][bj][m][n] = __builtin_amdgcn_mfma_f32_16x16x32_bf16(Bt_[n][k], At_[m][k], acc[ai][bj][m][n], 0, 0, 0); \
    __builtin_amdgcn_s_setprio(0); } while (0)
#define WAIT_V(n) asm volatile("s_waitcnt vmcnt(" #n ")" ::: "memory")
#define WAIT_L(n) asm volatile("s_waitcnt lgkmcnt(" #n ")" ::: "memory")
#define BAR __builtin_amdgcn_s_barrier()
#define SCHED __builtin_amdgcn_sched_barrier(0)
  const bf16_t *A, *Bt;
  if (!gen(0, A, Bt)) return;
  const int tid = otid(), wid = tid >> 6, lane = tid & 63, wr = wid >> 2, wc = wid & 3, fr = lane & 15, fq = lane >> 4;
  const int tb0 = tid * 16, tb1 = tid * 16 + 8192;
  int r0_, c0_;
  stage_rc(tb0, r0_, c0_);
  const int r0p = (r0_ & ~31) | perm32(r0_ & 31);
  const unsigned oa0 = (unsigned)(r0_ * lda + c0_), ob0 = (unsigned)(r0p * ldb + c0_);
  acc_t acc;
  bf16x8 At[4][2], B0[2][2], B1[2][2];
  STG_B(SB(0, 0), Bt); STG_A(SA(0, 0), A);
  STG_B(SB(0, 1), Bt + (size_t)128 * ldb); STG_A(SA(0, 1), A + (size_t)128 * lda);
  if (wr == 1) BAR;
  WAIT_V(4); BAR;
  STG_B(SB(1, 0), Bt + 64); STG_A(SA(1, 0), A + 64); STG_B(SB(1, 1), Bt + (size_t)128 * ldb + 64);
  WAIT_V(6); BAR;
  for (int i = 0;; ++i) {
    const bf16_t *An, *Bn;
    const bool more = gen(i + 1, An, Bn);
    if (!more) { An = A; Bn = Bt; }
#pragma unroll
    for (int a = 0; a < 2; ++a)
#pragma unroll
      for (int b = 0; b < 2; ++b)
#pragma unroll
        for (int m = 0; m < 4; ++m)
#pragma unroll
          for (int n = 0; n < 2; ++n) acc[a][b][m][n] = (f32x4){0.f, 0.f, 0.f, 0.f};
    for (int t = 0; t < nt; t += 2) {
      const bool wrap = (t + 2 >= nt);
      const bf16_t* a1 = A + (t + 1) * 64;
      const bf16_t* a2 = wrap ? An : A + (t + 2) * 64;
      const bf16_t* b2 = wrap ? Bn : Bt + (t + 2) * 64;
      LDB(B0, 0, 0); SCHED; LDA(At, 0, 0); STG_A(SA(1, 1), a1 + (size_t)128 * lda);
      WAIT_L(8); BAR; WAIT_L(0); MMA(0, 0, At, B0); BAR; SCHED;
      LDB(B1, 0, 1); STG_B(SB(0, 0), b2);
      BAR; WAIT_L(0); MMA(0, 1, At, B1); BAR;
      LDA(At, 0, 1); STG_A(SA(0, 0), a2);
      BAR; WAIT_L(0); MMA(1, 0, At, B0); BAR; SCHED;
      STG_B(SB(0, 1), b2 + (size_t)128 * ldb);
      WAIT_V(6); BAR; MMA(1, 1, At, B1); BAR;
      LDB(B0, 1, 0); SCHED; LDA(At, 1, 0); STG_A(SA(0, 1), a2 + (size_t)128 * lda);
      WAIT_L(8); BAR; WAIT_L(0); MMA(0, 0, At, B0); BAR; SCHED;
      LDB(B1, 1, 1); STG_B(SB(1, 0), b2 + 64);
      BAR; WAIT_L(0); MMA(0, 1, At, B1); BAR;
      LDA(At, 1, 1); STG_A(SA(1, 0), a2 + 64);
      BAR; WAIT_L(0); MMA(1, 0, At, B0); BAR; SCHED;
      STG_B(SB(1, 1), b2 + (size_t)128 * ldb + 64);
      WAIT_V(6); BAR; MMA(1, 1, At, B1); BAR;
    }
    epi(i, acc);
    if (!more) break;
    A = An; Bt = Bn;
  }
  WAIT_V(0);
  if (wr == 0) BAR;
  BAR;
#undef SA
#undef SB
#undef STG_A
#undef STG_B
#undef LDA
#undef LDB
#undef MMA
#undef WAIT_V
#undef WAIT_L
#undef BAR
#undef SCHED
}
DI bool tile_of(int t, bool lat_only, int ncols, int& rt, int& ct) {
  if (lat_only) { if (t >= 64 * ncols) return false; const int li = t & 63; ct = t >> 6; rt = (li >> 3) * 9 + 1 + (li & 7); return true; }
  if (t >= NRT * ncols) return false;
  rt = t % NRT; ct = t / NRT; return true;
}
template <class F>
DI void epi_foreach(acc_t& acc, F f) {
  const int tid = otid(), wid = tid >> 6, lane = tid & 63, wr = wid >> 2, wc = wid & 3, fr = lane & 15, fq = lane >> 4;
#pragma unroll
  for (int ai = 0; ai < 2; ++ai)
#pragma unroll
    for (int m = 0; m < 4; ++m) {
#pragma unroll
      for (int bj = 0; bj < 2; ++bj) f(ai * 128 + wr * 64 + m * 16 + fr, bj * 128 + wc * 32 + 8 * fq, acc[ai][bj][m][0], acc[ai][bj][m][1]);
      if (m & 1) __builtin_amdgcn_sched_barrier(0);
    }
}
template <int ACT  >
DI void store_bf16_tile(acc_t& acc, bf16_t* O, int ldo) {
  epi_foreach(acc, [&](int r, int c, f32x4& v0, f32x4& v1) {
    float o[8] = {v0[0], v0[1], v0[2], v0[3], v1[0], v1[1], v1[2], v1[3]};
    if (ACT == 1) {
#pragma unroll
      for (int j = 0; j < 8; ++j) { const float q = fmaxf(o[j], 0.f); o[j] = q * q; }
    }
    if (ACT == 2) {
#pragma unroll
      for (int j = 0; j < 8; ++j) o[j] = __builtin_amdgcn_rcpf(1.f + __builtin_amdgcn_exp2f(-LOG2E * o[j]));
    }
    u32x4 pk;
#pragma unroll
    for (int j = 0; j < 4; ++j) pk[j] = cvt_pk_bf16(o[2 * j], o[2 * j + 1]);
    *(u32x4*)(O + (size_t)r * ldo + c) = pk;
  });
}
template <bool ADD>
DI void gated_tile(acc_t& acc, bf16_t* Y, int ldy, const bf16_t* Gt, int ldg) {
  epi_foreach(acc, [&](int r, int c, f32x4& v0, f32x4& v1) {
    const u32x4 g = *(const u32x4*)(Gt + (size_t)r * ldg + c);
    float o[8];
    o[0] = bflo(g[0]) * v0[0]; o[1] = bfhi(g[0]) * v0[1]; o[2] = bflo(g[1]) * v0[2]; o[3] = bfhi(g[1]) * v0[3];
    o[4] = bflo(g[2]) * v1[0]; o[5] = bfhi(g[2]) * v1[1]; o[6] = bflo(g[3]) * v1[2]; o[7] = bfhi(g[3]) * v1[3];
    bf16_t* py = Y + (size_t)r * ldy + c;
    if (ADD) {
      const u32x4 y0 = *(const u32x4*)py;
#pragma unroll
      for (int j = 0; j < 4; ++j) { o[2 * j] += bflo(y0[j]); o[2 * j + 1] += bfhi(y0[j]); }
    }
    u32x4 pk;
#pragma unroll
    for (int j = 0; j < 4; ++j) pk[j] = cvt_pk_bf16(o[2 * j], o[2 * j + 1]);
    *(u32x4*)py = pk;
  });
}
DI void residual_tile(acc_t& acc, float* X, const float* gate, const float* Xin = nullptr) {
  const float* xs = Xin ? Xin : X;
  const int tid = otid(), wid = tid >> 6, lane = tid & 63, wc = wid & 3, fq = lane >> 4;
  f32x4 gv[2][2];
#pragma unroll
  for (int bj = 0; bj < 2; ++bj) { gv[bj][0] = *(const f32x4*)(gate + bj * 128 + wc * 32 + 8 * fq); gv[bj][1] = *(const f32x4*)(gate + bj * 128 + wc * 32 + 8 * fq + 4); }
  epi_foreach(acc, [&](int r, int c, f32x4& v0, f32x4& v1) {
    const int bj = c >> 7;
    f32x4 x0 = *(const f32x4*)(xs + (size_t)r * DM + c), x1 = *(const f32x4*)(xs + (size_t)r * DM + c + 4);
    x0 = x0 + (bj ? gv[1][0] : gv[0][0]) * v0; x1 = x1 + (bj ? gv[1][1] : gv[0][1]) * v1;
    *(f32x4*)(X + (size_t)r * DM + c) = x0; *(f32x4*)(X + (size_t)r * DM + c + 4) = x1;
  });
}

struct ConvDesc { const float* src; int ld, col0, K, N; bf16_t* dst; int ldd; const float* scale; };
DI void conv_tile(const ConvDesc& d, int ti, char* smem) {
  float* tile = (float*)smem;
  const int nkt = d.K >> 6;
  const int k0 = (ti % nkt) * 64, n0 = (ti / nkt) * 64;
  const int tid = otid();
#pragma unroll
  for (int i = 0; i < 2; ++i) {
    const int idx = tid + i * 512, kk = idx >> 4, n4 = (idx & 15) * 4;
    f32x4 v = (f32x4){0.f, 0.f, 0.f, 0.f};
    if (n0 + n4 < d.N) v = *(const f32x4*)(d.src + (size_t)(k0 + kk) * d.ld + d.col0 + n0 + n4);
    if (d.scale) v = v * d.scale[k0 + kk];
    tile[kk * 65 + n4] = v[0]; tile[kk * 65 + n4 + 1] = v[1]; tile[kk * 65 + n4 + 2] = v[2]; tile[kk * 65 + n4 + 3] = v[3];
  }
  __syncthreads();
  {
    const int nn = tid >> 3, kc = (tid & 7) * 8;
    if (n0 + nn < d.N) {
      u32x4 o;
#pragma unroll
      for (int j = 0; j < 4; ++j) o[j] = cvt_pk_bf16(tile[(kc + 2 * j) * 65 + nn], tile[(kc + 2 * j + 1) * 65 + nn]);
      *(u32x4*)(d.dst + (size_t)(n0 + nn) * d.ldd + k0 + kc) = o;
    }
  }
  __syncthreads();
}
DI void convert_weights(const Params& p, int l, char* smem, int t_first, int t_stride, int t_begin, int t_end) {
  char* ws = p.ws + wset(l);
  const float* win = p.w_in + (size_t)l * DM * INC;
  const int cnt[12] = {16 * 32, 16 * 12, 16 * 4, 16 * 24, 16 * 1, 12 * 12, 4 * 16, 8 * 16, 8 * 16, 16 * 16, 16 * 64, 64 * 16};
  int total = 0;
#pragma unroll
  for (int i = 0; i < 12; ++i) total += cnt[i];
  if (t_end > total) t_end = total;
  for (int t = t_begin + t_first; t < t_end; t += t_stride) {
    int which = 0, rem = t;
#pragma unroll
    for (int i = 0; i < 12; ++i) { if (which == i && rem >= cnt[i]) { rem -= cnt[i]; which = i + 1; } }
    ConvDesc d;
    switch (which) {
      case 0: d = {win, INC, 0, 1024, 2048, (bf16_t*)(ws + O_WG), 1024, nullptr}; break;
      case 1: d = {win, INC, 2048, 1024, 768, (bf16_t*)(ws + O_WP), 1024, nullptr}; break;
      case 2: d = {win, INC, 2816, 1024, 256, (bf16_t*)(ws + O_WP) + (size_t)768 * 1024, 1024, nullptr}; break;
      case 3: d = {win, INC, 3104, 1024, 1536, (bf16_t*)(ws + O_WP) + (size_t)1024 * 1024, 1024, nullptr}; break;
      case 4: d = {win, INC, 3072, 1024, 32, (bf16_t*)(ws + O_WP) + (size_t)2560 * 1024, 1024, nullptr}; break;
      case 5: d = {p.w_uq + (size_t)l * 768 * 768, 768, 0, 768, 768, (bf16_t*)(ws + O_WUQ), 768, p.g_qa + l * 768}; break;
      case 6: d = {p.w_ukv + (size_t)l * 256 * 1024, 1024, 0, 256, 1024, (bf16_t*)(ws + O_WUKV), 256, p.g_kva + l * 256}; break;
      case 7: d = {p.w_mla_o + (size_t)l * 512 * 1024, 1024, 0, 512, 1024, (bf16_t*)(ws + O_WMO), 512, nullptr}; break;
      case 8: d = {p.w_na_o + (size_t)l * 512 * 1024, 1024, 0, 512, 1024, (bf16_t*)(ws + O_WNO), 512, nullptr}; break;
      case 9: d = {p.w_out + (size_t)l * 1024 * 1024, 1024, 0, 1024, 1024, (bf16_t*)(ws + O_WOUT), 1024, nullptr}; break;
      case 10: d = {p.w_ff1 + (size_t)l * 1024 * 4096, 4096, 0, 1024, 4096, (bf16_t*)(ws + O_WFF1), 1024, nullptr}; break;
      default: d = {p.w_ff2 + (size_t)l * 4096 * 1024, 1024, 0, 4096, 1024, (bf16_t*)(ws + O_WFF2), 4096, nullptr}; break;
    }
    conv_tile(d, rem, smem);
  }
}
DI void zero_wp_pad(const Params& p, int l) {
  u32x4* z = (u32x4*)((bf16_t*)(p.ws + wset(l) + O_WP) + (size_t)2592 * 1024);
  const int n16 = 224 * 1024 * 2 / 16;
  for (int i = blockIdx.x * 512 + (int)threadIdx.x; i < n16; i += gridDim.x * 512) z[i] = (u32x4){0u, 0u, 0u, 0u};
}

DI void phase0(const Params& p, char* smem) {
  char* ws = p.ws;
  const int tid = otid();
  if (blockIdx.x == gridDim.x - 1) {
    float* tab = (float*)(ws + O_TAB);
    for (int i = tid; i < 512; i += 512) {
      const int pos = i >> 3, f = i & 7;
      const float inv = powf(10000.f, -(float)f / 8.f);
      const float ang = (float)pos * inv;
      tab[i * 2] = cosf(ang); tab[i * 2 + 1] = sinf(ang);
    }
  }
  float* sc = (float*)smem;
  float* red = (float*)(smem + 36864);
  float* mod = (float*)(ws + O_MOD);
  for (int it = blockIdx.x; it < NLAYER * 96; it += gridDim.x) {
    const int l = it / 96, cgp = it % 96;
    for (int idx = tid; idx < 9 * 1024; idx += 512) {
      const int r = idx >> 10, k = idx & 1023;
      const float v = (r < 8) ? p.c[r * 1024 + k] : p.c_ctx[k];
      sc[idx] = v / (1.f + expf(-v));
    }
    __syncthreads();
    const int w = tid >> 6, lane = tid & 63, col = cgp * 64 + lane;
    float a[9];
#pragma unroll
    for (int r = 0; r < 9; ++r) a[r] = 0.f;
    const float* wp = p.w_ada + (size_t)l * 1024 * 6144 + col;
#pragma unroll 4
    for (int k = w * 128; k < w * 128 + 128; ++k) {
      const float wv = wp[(size_t)k * 6144];
#pragma unroll
      for (int r = 0; r < 9; ++r) a[r] += sc[r * 1024 + k] * wv;
    }
#pragma unroll
    for (int r = 0; r < 9; ++r) red[(w * 9 + r) * 64 + lane] = a[r];
    __syncthreads();
    for (int idx = tid; idx < 9 * 64; idx += 512) {
      const int r = idx >> 6, ln = idx & 63;
      float s = 0.f;
#pragma unroll
      for (int ww = 0; ww < 8; ++ww) s += red[(ww * 9 + r) * 64 + ln];
      mod[(size_t)(l * 9 + r) * 6144 + cgp * 64 + ln] = s + p.b_ada[l * 6144 + cgp * 64 + ln];
    }
    __syncthreads();
  }
}

DI void phase_norm(const Params& p, int l, const float* g, int shift_idx, bool skip_ctx, bool from_input) {
  const int tid = otid(), lane = tid & 63, w = tid >> 6;
  const float* mod = (const float*)(p.ws + O_MOD) + (size_t)l * 9 * 6144;
  bf16_t* hb = (bf16_t*)(p.ws + O_HB);
  const int stride = gridDim.x * 8;
  for (int row0 = blockIdx.x * 8 + w; row0 < TT; row0 += 2 * stride) {
    f32x4 v[2][4];
    bool act[2];
    int rows[2];
#pragma unroll
    for (int u = 0; u < 2; ++u) {
      const int row = row0 + u * stride;
      rows[u] = row;
      const int b = row / TPB, t = row - b * TPB;
      act[u] = (row < TT) && !(skip_ctx && t < CTXL);
      if (act[u]) {
        const float* xr = xrow_src(p, row, from_input);
#pragma unroll
        for (int i = 0; i < 4; ++i) v[u][i] = *(const f32x4*)(xr + lane * 4 + i * 256);
      } else {
#pragma unroll
        for (int i = 0; i < 4; ++i) v[u][i] = (f32x4){0.f, 0.f, 0.f, 0.f};
      }
    }
#pragma unroll
    for (int u = 0; u < 2; ++u) {
      if (!act[u]) continue;
      const int row = rows[u];
      const int b = row / TPB, t = row - b * TPB;
      float ss = 0.f;
#pragma unroll
      for (int i = 0; i < 4; ++i) ss += v[u][i][0] * v[u][i][0] + v[u][i][1] * v[u][i][1] + v[u][i][2] * v[u][i][2] + v[u][i][3] * v[u][i][3];
      ss = wave_sum(ss);
      const float rs = rsqrtf(ss * (1.f / 1024.f) + EPS);
      const float* mr = mod + (size_t)(t < CTXL ? 8 : b) * 6144 + shift_idx * 1024;
#pragma unroll
      for (int i = 0; i < 4; ++i) {
        const int col = lane * 4 + i * 256;
        const f32x4 gg = *(const f32x4*)(g + col), sh = *(const f32x4*)(mr + col), scl = *(const f32x4*)(mr + 1024 + col);
        f32x4 y = (v[u][i] * rs) * gg;
        y = y * (scl + 1.f) + sh;
        u32x2 pk; pk.x = cvt_pk_bf16(y[0], y[1]); pk.y = cvt_pk_bf16(y[2], y[3]);
        *(u32x2*)(hb + (size_t)row * 1024 + col) = pk;
      }
    }
  }
}

DI void rowstats_item(const Params& p, int item) {
  const int tid = otid(), lane = tid & 63, w = tid >> 6;
  const bf16_t* pb = (const bf16_t*)(p.ws + O_PB);
  float* st = (float*)(p.ws + O_STAT);
#pragma unroll 1
  for (int i = 0; i < 2; ++i) {
    const int row = item * 16 + w * 2 + i;
    const bf16_t* pr = pb + (size_t)row * PBW;
    float sq = 0.f, sk = 0.f;
    {
      u32x4 u = *(const u32x4*)(pr + lane * 8);
#pragma unroll
      for (int j = 0; j < 4; ++j) { float a = bflo(u[j]), b2 = bfhi(u[j]); sq += a * a + b2 * b2; }
    }
    if (lane < 32) {
      u32x4 u = *(const u32x4*)(pr + 512 + lane * 8);
#pragma unroll
      for (int j = 0; j < 4; ++j) { float a = bflo(u[j]), b2 = bfhi(u[j]); sq += a * a + b2 * b2; }
      u32x4 u2 = *(const u32x4*)(pr + 768 + lane * 8);
#pragma unroll
      for (int j = 0; j < 4; ++j) { float a = bflo(u2[j]), b2 = bfhi(u2[j]); sk += a * a + b2 * b2; }
    }
    sq = wave_sum(sq); sk = wave_sum(sk);
    if (lane == 0) { st[row * 2] = rsqrtf(sq * (1.f / 768.f) + EPS); st[row * 2 + 1] = rsqrtf(sk * (1.f / 256.f) + EPS); }
  }
}

DI void rope8(float (&x1)[8], float (&x2)[8], const float* tabrow) {
#pragma unroll
  for (int i = 0; i < 8; ++i) {
    const float c = tabrow[i * 2], s = tabrow[i * 2 + 1];
    const float a = x1[i], b = x2[i];
    x1[i] = a * c - b * s; x2[i] = a * s + b * c;
  }
}
DI void unpack8(const u32x4& u, float (&f)[8]) {
#pragma unroll
  for (int j = 0; j < 4; ++j) { f[2 * j] = bflo(u[j]); f[2 * j + 1] = bfhi(u[j]); }
}
DI u32x4 pack8(const float (&f)[8]) {
  u32x4 u;
#pragma unroll
  for (int j = 0; j < 4; ++j) u[j] = cvt_pk_bf16(f[2 * j], f[2 * j + 1]);
  return u;
}
DI float sumsq8(const u32x4& u) {
  float s = 0.f;
#pragma unroll
  for (int j = 0; j < 4; ++j) { float a = bflo(u[j]), b = bfhi(u[j]); s += a * a + b * b; }
  return s;
}
template <int NCH, bool ROPE>
DI void norm_rows16(int lane, size_t row0, bool is_ctx, int t0, const bf16_t* srcA, size_t ldA, int nA, const bf16_t* srcB, size_t ldB,
                    const float* st, int st_idx, const float* gain, float inv_n, bf16_t* dst, size_t ldd, const float* tab) {
  const int sub = lane & 15, tq = lane >> 4;
  const bool actv = sub < NCH, fromA = sub < nA;
  float gv[8];
#pragma unroll
  for (int j = 0; j < 8; ++j) gv[j] = actv ? gain[sub * 8 + j] : 0.f;
  u32x4 ua[16];
  float prea[16];
#pragma unroll
  for (int it = 0; it < 16; ++it) {
    const size_t row = row0 + it * 4 + tq;
    ua[it] = (u32x4){0u, 0u, 0u, 0u};
    if (actv) ua[it] = *(const u32x4*)(fromA ? srcA + row * ldA + sub * 8 : srcB + row * ldB + (sub - nA) * 8);
    prea[it] = 1.f;
    if (st_idx >= 0 && fromA) prea[it] = st[row * 2 + st_idx];
  }
#pragma unroll
  for (int it = 0; it < 16; ++it) {
    const int tk = it * 4 + tq;
    const size_t row = row0 + tk;
    const u32x4 u = ua[it];
    const float pre = prea[it];
    float f[8];
    unpack8(u, f);
    float ss = 0.f;
#pragma unroll
    for (int j = 0; j < 8; ++j) { f[j] *= pre; ss += f[j] * f[j]; }
    ss += __shfl_xor(ss, 1); ss += __shfl_xor(ss, 2); ss += __shfl_xor(ss, 4); ss += __shfl_xor(ss, 8);
    const float rs = rsqrtf(ss * inv_n + EPS);
#pragma unroll
    for (int j = 0; j < 8; ++j) f[j] *= rs * gv[j];
    if (ROPE) {
      float pf[8];
#pragma unroll
      for (int j = 0; j < 8; ++j) pf[j] = __shfl_xor(f[j], 1);
      if (!is_ctx && sub >= 8 && sub < 12) {
        const int pos = t0 + tk - CTXL;
        const float* tr = tab + ((sub < 10) ? (pos >> 6) : (pos & 63)) * 16;
#pragma unroll
        for (int j = 0; j < 8; ++j) {
          const float c = tr[2 * j], sn = tr[2 * j + 1];
          f[j] = (sub & 1) ? (pf[j] * sn + f[j] * c) : (f[j] * c - pf[j] * sn);
        }
      }
    }
    if (actv) *(u32x4*)(dst + row * ldd + sub * 8) = pack8(f);
  }
}
DI void copy_rows8(int lane, size_t row0, const bf16_t* src, size_t lds_, const float* st, bf16_t* dst, size_t ldd) {
  const int sub = lane & 7, tq = lane >> 3;
  u32x4 ua[8];
  float sc[8];
#pragma unroll
  for (int it = 0; it < 8; ++it) {
    const size_t row = row0 + it * 8 + tq;
    ua[it] = *(const u32x4*)(src + row * lds_ + sub * 8);
    sc[it] = st ? st[row * 2 + 1] : 1.f;
  }
#pragma unroll
  for (int it = 0; it < 8; ++it) {
    const size_t row = row0 + it * 8 + tq;
    float f[8];
    unpack8(ua[it], f);
#pragma unroll
    for (int j = 0; j < 8; ++j) f[j] *= sc[it];
    *(u32x4*)(dst + row * ldd + sub * 8) = pack8(f);
  }
}
DI void finalize_wave_item(const Params& p, int l, int wi) {
  char* ws = p.ws;
  const int lane = otid() & 63;
  const int part = wi % 3, rest = wi / 3, h = rest & 7, g = rest >> 3;
  const int row = g * 64 + lane;
  const size_t row0 = (size_t)g * 64;
  const int b = g / 36, t0 = (g % 36) * 64, t = t0 + lane;
  const bool is_ctx = t0 < CTXL;
  const float* tab = (const float*)(ws + O_TAB);
  const bf16_t* pb0 = (const bf16_t*)(ws + O_PB);
  const bf16_t* qk0 = (const bf16_t*)(ws + O_QK2);
  const bf16_t* pb = pb0 + (size_t)row * PBW;
  const bf16_t* qk = qk0 + (size_t)row * QKW;
  const float* st0 = (const float*)(ws + O_STAT);
  const float* st = st0 + row * 2;
  if (part == 0) {
    norm_rows16<12, true>(lane, row0, is_ctx, t0, qk0 + h * 96, QKW, 12, qk0, QKW, st0, 0, p.g_mla_q + l * 96, 1.f / 96.f,
                          (bf16_t*)(ws + O_MQ) + h * 96, 768, tab);
  } else if (part == 1) {
    norm_rows16<12, true>(lane, row0, is_ctx, t0, qk0 + 768 + h * 128, QKW, 8, pb0 + 2560, PBW, st0, 1, p.g_mla_k + l * 96, 1.f / 96.f,
                          (bf16_t*)(ws + O_MK) + h * 96, 768, tab);
    copy_rows8(lane, row0, qk0 + 768 + h * 128 + 64, QKW, st0, (bf16_t*)(ws + O_MVT) + h * 64, 512);
  } else {
    norm_rows16<8, false>(lane, row0, is_ctx, t0, pb0 + 1024 + h * 64, PBW, 8, pb0, PBW, st0, -1, p.g_na_q + l * 64, 1.f / 64.f,
                          (bf16_t*)(ws + O_NQ) + h * 64, 512, tab);
    norm_rows16<8, false>(lane, row0, is_ctx, t0, pb0 + 1536 + h * 64, PBW, 8, pb0, PBW, st0, -1, p.g_na_k + l * 64, 1.f / 64.f,
                          (bf16_t*)(ws + O_NK) + h * 64, 512, tab);
  }
}

template <int DQK, bool NA, bool SMAX, int LDV>
DI void attn_item(const bf16_t* __restrict__ Qp, int ldq, const bf16_t* __restrict__ Kp, int ldk, const bf16_t* __restrict__ Vp  ,
                  int nkt, int koff, float c1, float m0, int r0, int rs, const float* __restrict__ rpb_g, bf16_t* __restrict__ Op, char* smem) {
  constexpr int KSTR = DQK * 2 + 32, KBYTES = 64 * KSTR, VSTR = 160, VBYTES = 64 * VSTR, STG = KBYTES + VBYTES;
  constexpr int CPK = DQK / 8, NKC = (64 * CPK + 511) / 512, NDS = DQK / 32;
  const int tid = otid(), lane = tid & 63, w = tid >> 6, fr = lane & 15, fq = lane >> 4;
  float* rpbl = (float*)(smem + 2 * STG);
  if (NA) { for (int i = tid; i < 465; i += 512) rpbl[i] = rpb_g[i] * LOG2E; }
  bf16x8 qf[2][NDS];
#pragma unroll
  for (int qt = 0; qt < 2; ++qt)
#pragma unroll
    for (int ds = 0; ds < NDS; ++ds) qf[qt][ds] = *(const bf16x8*)(Qp + (size_t)(w * 32 + qt * 16 + fr) * ldq + ds * 32 + fq * 8);
  u32x4 rkA[NKC], rvA, rkB[NKC], rvB;
  int kkey[NKC], kcc[NKC];
  bool kval[NKC];
#pragma unroll
  for (int i = 0; i < NKC; ++i) { const int c = tid + i * 512; kval[i] = c < 64 * CPK; kkey[i] = kval[i] ? c / CPK : 0; kcc[i] = kval[i] ? c - kkey[i] * CPK : 0; }
  const int vdv = tid >> 3, vcc = tid & 7;
  {
#pragma unroll
    for (int i = 0; i < NKC; ++i) rkA[i] = *(const u32x4*)(Kp + (size_t)kkey[i] * ldk + kcc[i] * 8);
    rvA = *(const u32x4*)(Vp + (size_t)vdv * LDV + vcc * 8);
    if (nkt > 1) {
      const int kb = 64;
#pragma unroll
      for (int i = 0; i < NKC; ++i) rkB[i] = *(const u32x4*)(Kp + (size_t)(kb + kkey[i]) * ldk + kcc[i] * 8);
      rvB = *(const u32x4*)(Vp + (size_t)(kb + vdv) * LDV + vcc * 8);
    }
#pragma unroll
    for (int i = 0; i < NKC; ++i) if (kval[i]) *(u32x4*)(smem + kkey[i] * KSTR + kcc[i] * 16) = rkA[i];
    *(u32x4*)(smem + KBYTES + vdv * VSTR + vcc * 16) = rvA;
  }
  __syncthreads();
  f32x4 o[4][2];
  float mrun[2], lrun[2];
#pragma unroll
  for (int qt = 0; qt < 2; ++qt) {
    mrun[qt] = -1e30f; lrun[qt] = 0.f;
#pragma unroll
    for (int d = 0; d < 4; ++d) o[d][qt] = (f32x4){0.f, 0.f, 0.f, 0.f};
  }
  auto step = [&](const int it, u32x4 (&rk_ld)[NKC], u32x4& rv_ld, u32x4 (&rk_wr)[NKC], u32x4& rv_wr) __attribute__((always_inline)) {
    const int cur = it & 1;
    const bool more = it + 1 < nkt;
    if (it + 2 < nkt) {
      const int kb = (it + 2) * 64 + ((it + 2) >= 4 ? koff : 0);
#pragma unroll
      for (int i = 0; i < NKC; ++i) rk_ld[i] = *(const u32x4*)(Kp + (size_t)(kb + kkey[i]) * ldk + kcc[i] * 8);
      rv_ld = *(const u32x4*)(Vp + (size_t)(kb + vdv) * LDV + vcc * 8);
    }
    __builtin_amdgcn_sched_barrier(0);
    const char* ks = smem + cur * STG;
    const char* vs = ks + KBYTES;
    f32x4 s[4][2];
#pragma unroll
    for (int kt = 0; kt < 4; ++kt) { s[kt][0] = (f32x4){0.f, 0.f, 0.f, 0.f}; s[kt][1] = (f32x4){0.f, 0.f, 0.f, 0.f}; }
#pragma unroll
    for (int ds = 0; ds < NDS; ++ds) {
      bf16x8 kf[4];
#pragma unroll
      for (int kt = 0; kt < 4; ++kt) kf[kt] = *(const bf16x8*)(ks + (kt * 16 + fr) * KSTR + ds * 64 + fq * 16);
#pragma unroll
      for (int kt = 0; kt < 4; ++kt) {
        s[kt][0] = __builtin_amdgcn_mfma_f32_16x16x32_bf16(kf[kt], qf[0][ds], s[kt][0], 0, 0, 0);
        s[kt][1] = __builtin_amdgcn_mfma_f32_16x16x32_bf16(kf[kt], qf[1][ds], s[kt][1], 0, 0, 0);
      }
    }
    bf16x8 vfr[2][4];
#pragma unroll
    for (int k2 = 0; k2 < 2; ++k2)
#pragma unroll
      for (int d = 0; d < 4; ++d) {
        const char* vp = vs + (k2 * 32 + fq * 4 + (fr >> 2)) * VSTR + d * 32 + (fr & 3) * 8;
        typedef short s16x4_t __attribute__((ext_vector_type(4)));
        const s16x4_t lo = __builtin_amdgcn_ds_read_tr16_b64_v4i16((__attribute__((address_space(3))) s16x4_t*)(vp));
        const s16x4_t hi = __builtin_amdgcn_ds_read_tr16_b64_v4i16((__attribute__((address_space(3))) s16x4_t*)(vp + 16 * VSTR));
        vfr[k2][d] = __builtin_shufflevector(lo, hi, 0, 1, 2, 3, 4, 5, 6, 7);
      }
    __builtin_amdgcn_sched_barrier(0);
    if (SMAX) {
#pragma unroll
      for (int qt = 0; qt < 2; ++qt) {
        float sum = 0.f;
        if (NA && it >= 4) {
          const int kr = rs + (it - 4);
          const int ql = w * 32 + qt * 16 + fr, qr = r0 + (ql >> 6), qc = ql & 63;
          const int rst = min(max(qr - 4, 0), 24);
          const bool rowok = (kr >= rst) && (kr < rst + 8);
          const int cst = min(max(qc - 8, 0), 48);
          const int base = (kr - qr + 7) * 31 + 15 - qc;
          float bv[4][4];
#pragma unroll
          for (int kt = 0; kt < 4; ++kt)
#pragma unroll
            for (int j = 0; j < 4; ++j) bv[kt][j] = rpbl[min(max(base + kt * 16 + fq * 4 + j, 0), 464)];
#pragma unroll
          for (int kt = 0; kt < 4; ++kt)
#pragma unroll
            for (int j = 0; j < 4; ++j) {
              const int kc = kt * 16 + fq * 4 + j;
              const float okf = (rowok && (kc >= cst) && (kc < cst + 16)) ? 1.f : 0.f;
              const float pv = __builtin_amdgcn_exp2f(__builtin_fmaf(s[kt][qt][j], c1, bv[kt][j] - m0)) * okf;
              s[kt][qt][j] = pv; sum += pv;
            }
        } else {
#pragma unroll
          for (int kt = 0; kt < 4; ++kt)
#pragma unroll
            for (int j = 0; j < 4; ++j) { const float pv = __builtin_amdgcn_exp2f(__builtin_fmaf(s[kt][qt][j], c1, -m0)); s[kt][qt][j] = pv; sum += pv; }
        }
        lrun[qt] += sum;
      }
    } else {
#pragma unroll
    for (int qt = 0; qt < 2; ++qt) {
      float mx = -1e30f;
      if (NA && it >= 4) {
        const int kr = rs + (it - 4);
        const int ql = w * 32 + qt * 16 + fr, qr = r0 + (ql >> 6), qc = ql & 63;
        const int rst = min(max(qr - 4, 0), 24);
        const bool rowok = (kr >= rst) && (kr < rst + 8);
        const int cst = min(max(qc - 8, 0), 48);
        const int base = (kr - qr + 7) * 31 + 15 - qc;
        float bv[4][4];
#pragma unroll
        for (int kt = 0; kt < 4; ++kt)
#pragma unroll
          for (int j = 0; j < 4; ++j) bv[kt][j] = rpbl[min(max(base + kt * 16 + fq * 4 + j, 0), 464)];
#pragma unroll
        for (int kt = 0; kt < 4; ++kt)
#pragma unroll
          for (int j = 0; j < 4; ++j) {
            const int kc = kt * 16 + fq * 4 + j;
            const float okf = (rowok && (kc >= cst) && (kc < cst + 16)) ? 1.f : 0.f;
            const float tv = __builtin_fmaf(s[kt][qt][j], c1, bv[kt][j]) * okf - (1.f - okf) * 1e30f;
            s[kt][qt][j] = tv; mx = fmaxf(mx, tv);
          }
      } else {
#pragma unroll
        for (int kt = 0; kt < 4; ++kt)
#pragma unroll
          for (int j = 0; j < 4; ++j) { const float tv = s[kt][qt][j] * c1; s[kt][qt][j] = tv; mx = fmaxf(mx, tv); }
      }
      mx = fmaxf(mx, __shfl_xor(mx, 16));
      mx = fmaxf(mx, __shfl_xor(mx, 32));
      const float mnew = fmaxf(mrun[qt], mx);
      const float alpha = __builtin_amdgcn_exp2f(mrun[qt] - mnew);
      mrun[qt] = mnew;
      float sum = 0.f;
#pragma unroll
      for (int kt = 0; kt < 4; ++kt)
#pragma unroll
        for (int j = 0; j < 4; ++j) { const float pv = __builtin_amdgcn_exp2f(s[kt][qt][j] - mnew); s[kt][qt][j] = pv; sum += pv; }
      lrun[qt] = lrun[qt] * alpha + sum;
#pragma unroll
      for (int d = 0; d < 4; ++d) o[d][qt] = o[d][qt] * alpha;
    }
    }
#pragma unroll
    for (int k2 = 0; k2 < 2; ++k2) {
      bf16x8 pf[2];
#pragma unroll
      for (int qt = 0; qt < 2; ++qt) {
        u32x4 u;
        u[0] = cvt_pk_bf16(s[2 * k2][qt][0], s[2 * k2][qt][1]); u[1] = cvt_pk_bf16(s[2 * k2][qt][2], s[2 * k2][qt][3]);
        u[2] = cvt_pk_bf16(s[2 * k2 + 1][qt][0], s[2 * k2 + 1][qt][1]); u[3] = cvt_pk_bf16(s[2 * k2 + 1][qt][2], s[2 * k2 + 1][qt][3]);
        pf[qt] = __builtin_bit_cast(bf16x8, u);
      }
#pragma unroll
      for (int d = 0; d < 4; ++d) {
        o[d][0] = __builtin_amdgcn_mfma_f32_16x16x32_bf16(vfr[k2][d], pf[0], o[d][0], 0, 0, 0);
        o[d][1] = __builtin_amdgcn_mfma_f32_16x16x32_bf16(vfr[k2][d], pf[1], o[d][1], 0, 0, 0);
      }
    }
    if (more) {
      char* nx = smem + (cur ^ 1) * STG;
#pragma unroll
      for (int i = 0; i < NKC; ++i) if (kval[i]) *(u32x4*)(nx + kkey[i] * KSTR + kcc[i] * 16) = rk_wr[i];
      *(u32x4*)(nx + KBYTES + vdv * VSTR + vcc * 16) = rv_wr;
    }
    __syncthreads();
  };
  for (int it = 0; it < nkt; it += 2) {
    step(it, rkA, rvA, rkB, rvB);
    if (it + 1 < nkt) step(it + 1, rkB, rvB, rkA, rvA);
  }
#pragma unroll
  for (int qt = 0; qt < 2; ++qt) {
    float lt = lrun[qt];
    lt += __shfl_xor(lt, 16);
    lt += __shfl_xor(lt, 32);
    const float inv = 1.f / lt;
#pragma unroll
    for (int d = 0; d < 4; ++d) {
      u32x2 pk; pk.x = cvt_pk_bf16(o[d][qt][0] * inv, o[d][qt][1] * inv); pk.y = cvt_pk_bf16(o[d][qt][2] * inv, o[d][qt][3] * inv);
      *(u32x2*)(Op + (size_t)(w * 32 + qt * 16 + fr) * 512 + d * 16 + fq * 4) = pk;
    }
  }
}

DI void phase_attn(const Params& p, int l, bool last, char* smem) {
  char* ws = p.ws;
  const bf16_t* mq = (const bf16_t*)(ws + O_MQ); const bf16_t* mk = (const bf16_t*)(ws + O_MK); const bf16_t* mvt = (const bf16_t*)(ws + O_MVT);
  const bf16_t* nq = (const bf16_t*)(ws + O_NQ); const bf16_t* nk = (const bf16_t*)(ws + O_NK);
  const bf16_t* pbv = (const bf16_t*)(ws + O_PB) + 2048;
  bf16_t* ymla = (bf16_t*)(ws + O_YMLA); bf16_t* yna = (bf16_t*)(ws + O_YNA);
  const float c_mla = LOG2E * 0.10206207261596575f;
  const float c_na = LOG2E * 0.125f;
  float m0_mla, m0_na;
  {
    const int tid = otid();
    float a = 0.f, b2 = 0.f, c = 0.f, d = 0.f, e = 0.f;
    if (tid < 96) { a = fabsf(p.g_mla_q[l * 96 + tid]); b2 = fabsf(p.g_mla_k[l * 96 + tid]); }
    if (tid < 64) { c = fabsf(p.g_na_q[l * 64 + tid]); d = fabsf(p.g_na_k[l * 64 + tid]); }
    for (int i = tid; i < 8 * 465; i += 512) e = fmaxf(e, p.rpb[(size_t)l * 8 * 465 + i]);
#pragma unroll
    for (int o = 32; o >= 1; o >>= 1) { a = fmaxf(a, __shfl_xor(a, o)); b2 = fmaxf(b2, __shfl_xor(b2, o)); c = fmaxf(c, __shfl_xor(c, o)); d = fmaxf(d, __shfl_xor(d, o)); e = fmaxf(e, __shfl_xor(e, o)); }
    float* red = (float*)smem;
    if ((tid & 63) == 0) { const int w = tid >> 6; red[w * 8 + 0] = a; red[w * 8 + 1] = b2; red[w * 8 + 2] = c; red[w * 8 + 3] = d; red[w * 8 + 4] = e; }
    __syncthreads();
    a = b2 = c = d = e = 0.f;
#pragma unroll
    for (int w = 0; w < 8; ++w) { a = fmaxf(a, red[w * 8]); b2 = fmaxf(b2, red[w * 8 + 1]); c = fmaxf(c, red[w * 8 + 2]); d = fmaxf(d, red[w * 8 + 3]); e = fmaxf(e, red[w * 8 + 4]); }
    __syncthreads();
    m0_mla = c_mla * 96.f * a * b2;
    m0_na = c_na * 64.f * c * d + e * LOG2E;
  }
  const bool smax_mla = m0_mla < 64.f, smax_na = m0_na < 64.f;
  for (int item = blockIdx.x; item < 1024; item += gridDim.x) {
    const int kind = item >> 9, it2 = item & 511;
    const int xx = it2 & 7, yy = it2 >> 3;
    const int bh = xx + 8 * (yy >> 3), qt = yy & 7;
    const int b = bh >> 3, h = bh & 7;
    const int q0 = b * TPB + CTXL + qt * 256;
    if (kind == 0) {
      if (smax_mla) attn_item<96, false, true, 512>(mq + (size_t)q0 * 768 + h * 96, 768, mk + (size_t)b * TPB * 768 + h * 96, 768, mvt + (size_t)b * TPB * 512 + h * 64,
                           36, 0, c_mla, m0_mla, 0, 0, nullptr, ymla + (size_t)q0 * 512 + h * 64, smem);
      else attn_item<96, false, false, 512>(mq + (size_t)q0 * 768 + h * 96, 768, mk + (size_t)b * TPB * 768 + h * 96, 768, mvt + (size_t)b * TPB * 512 + h * 64,
                           36, 0, c_mla, 0.f, 0, 0, nullptr, ymla + (size_t)q0 * 512 + h * 64, smem);
    } else {
      const int r0 = qt * 4;
      const int rs = min(max(r0 - 4, 0), 24);
      const int re = min(max(r0 + 3 - 4, 0), 24) + 8;
      if (smax_na) attn_item<64, true, true, PBW>(nq + (size_t)q0 * 512 + h * 64, 512, nk + (size_t)b * TPB * 512 + h * 64, 512, pbv + (size_t)b * TPB * PBW + h * 64,
                          4 + (re - rs), rs * 64, c_na, m0_na, r0, rs, p.rpb + ((size_t)l * 8 + h) * 465, yna + (size_t)q0 * 512 + h * 64, smem);
      else attn_item<64, true, false, PBW>(nq + (size_t)q0 * 512 + h * 64, 512, nk + (size_t)b * TPB * 512 + h * 64, 512, pbv + (size_t)b * TPB * PBW + h * 64,
                          4 + (re - rs), rs * 64, c_na, 0.f, r0, rs, p.rpb + ((size_t)l * 8 + h) * 465, yna + (size_t)q0 * 512 + h * 64, smem);
    }
  }
  {
    const bf16_t* hbp = (const bf16_t*)(ws + O_HB);
    const bf16_t* wg = (const bf16_t*)(ws + wset(l) + O_WG);
    bf16_t* gp = (bf16_t*)(ws + O_GATE);
    const int b0 = blockIdx.x, Gd = gridDim.x;
    gemm_stream<1024, 1024, 1024>(
        [&](int i, const bf16_t*& A, const bf16_t*& B) {
          int rt, ct;
          if (!tile_of(b0 + i * Gd, true, 8, rt, ct)) return false;
          A = hbp + (size_t)rt * 256 * 1024; B = wg + (size_t)ct * 256 * 1024; return true;
        },
        [&](int i, acc_t& acc) {
          int rt, ct;
          tile_of(b0 + i * Gd, true, 8, rt, ct);
          store_bf16_tile<2>(acc, gp + (size_t)rt * 256 * PBW + ct * 256, PBW);
        });
  }
  if (!last) {
    for (int it2 = blockIdx.x; it2 < 128; it2 += gridDim.x) {
      const int kind = it2 >> 6, bh = it2 & 63;
      const int b = bh >> 3, h = bh & 7;
      const int q0 = b * TPB;
      if (kind == 0)
        attn_item<96, false, false, 512>(mq + (size_t)q0 * 768 + h * 96, 768, mk + (size_t)b * TPB * 768 + h * 96, 768, mvt + (size_t)b * TPB * 512 + h * 64,
                             4, 0, c_mla, 0.f, 0, 0, nullptr, ymla + (size_t)q0 * 512 + h * 64, smem);
      else
        attn_item<64, false, false, PBW>(nq + (size_t)q0 * 512 + h * 64, 512, nk + (size_t)b * TPB * 512 + h * 64, 512, pbv + (size_t)b * TPB * PBW + h * 64,
                             4, 0, c_na, 0.f, 0, 0, nullptr, yna + (size_t)q0 * 512 + h * 64, smem);
    }
  }
}

#define XB_TMO      128
#define XB_XCNT(j)  (256  + 64 * (j))
#define XB_XSUB(j)  (1280 + 64 * (j))
#define XB_XGEN(j)  (2304 + 64 * (j))
#define XB_TOP      3328
#define XB_TOPGEN   3392
#define XCD_BAR_WORDS 3456
#define XB_SPIN_CAP (1u << 18)
#define LAS __attribute__((address_space(3)))

__device__ __forceinline__ unsigned xb_ld(unsigned* p)              { return __hip_atomic_load(p, __ATOMIC_RELAXED, __HIP_MEMORY_SCOPE_AGENT); }
__device__ __forceinline__ unsigned xb_add(unsigned* p, unsigned v) { return __hip_atomic_fetch_add(p, v, __ATOMIC_RELAXED, __HIP_MEMORY_SCOPE_AGENT); }
__device__ __forceinline__ unsigned xb_xcc_id() { return (unsigned)__builtin_amdgcn_s_getreg((3 << 11) | 20) & 0xFu; }
#define XB_SPIN(cond, bar) do { unsigned _sp = 0; while (cond) { __builtin_amdgcn_s_sleep(1); \
    if ((++_sp & 255u) == 0u) { if (xb_ld(&(bar)[XB_TMO])) break; if (_sp > XB_SPIN_CAP) { atomicAdd(&(bar)[XB_TMO], 1u); break; } } } } while (0)

struct XcdBarrier {
    unsigned* bar; unsigned x;
    volatile LAS unsigned* st;
};

__device__ __forceinline__ XcdBarrier xcd_barrier_post(unsigned* bar, volatile LAS unsigned* st) {
    XcdBarrier b; b.bar = bar; b.x = xb_xcc_id(); b.st = st;
    if (threadIdx.x == 0) (void)xb_add(&bar[XB_XCNT(b.x)], 1u);
    return b;
}
__device__ __forceinline__ void xcd_barrier_complete(unsigned* bar, unsigned x, unsigned& nloc, unsigned& nx) {
    const unsigned G = gridDim.x * gridDim.y * gridDim.z;
    unsigned sum, cnt, mine, sp = 0u;
    for (;;) {
        sum = 0u; cnt = 0u; mine = 0u;
#pragma unroll
        for (unsigned j = 0; j < 16; ++j) { const unsigned c = xb_ld(&bar[XB_XCNT(j)]); sum += c; cnt += (c > 0u) ? 1u : 0u; mine = (j == x) ? c : mine; }
        if (sum == G) break;
        __builtin_amdgcn_s_sleep(1);
        if ((++sp & 255u) == 0u) { if (xb_ld(&bar[XB_TMO])) break; if (sp > XB_SPIN_CAP) { atomicAdd(&bar[XB_TMO], 1u); break; } }
    }
    nloc = mine > 0u ? mine : 1u; nx = cnt > 0u ? cnt : 1u;
}

__device__ __forceinline__ void xcd_barrier(const XcdBarrier& b) {
    asm volatile("s_waitcnt vmcnt(0)" ::: "memory");
    __syncthreads();
    if (threadIdx.x == 0) {
        unsigned* bar = b.bar;
        __builtin_amdgcn_s_waitcnt(0);
        unsigned nloc = b.st[0], nx = b.st[1];
        if (nloc == 0u) { xcd_barrier_complete(bar, b.x, nloc, nx); b.st[0] = nloc; b.st[1] = nx; }
        const unsigned old = xb_add(&bar[XB_XSUB(b.x)], 1u);
        const unsigned gen = old / nloc;
        if (old + 1u == (gen + 1u) * nloc) {
            __builtin_amdgcn_fence(__ATOMIC_RELEASE, "agent");
            asm volatile("s_waitcnt vmcnt(0)" ::: "memory");
            const unsigned og = xb_add(&bar[XB_TOP], 1u);
            const unsigned tg = og / nx;
            if (og + 1u == (tg + 1u) * nx) xb_add(&bar[XB_TOPGEN], 1u);
            else XB_SPIN(xb_ld(&bar[XB_TOPGEN]) == tg, bar);
            __builtin_amdgcn_fence(__ATOMIC_ACQUIRE, "agent");
            xb_add(&bar[XB_XGEN(b.x)], 1u);
            asm volatile("s_waitcnt vmcnt(0)" ::: "memory");
        } else {
            XB_SPIN(xb_ld(&bar[XB_XGEN(b.x)]) == gen, bar);
            __builtin_amdgcn_fence(__ATOMIC_ACQUIRE, "agent");
            asm volatile("s_waitcnt vmcnt(0)" ::: "memory");
        }
    }
    __syncthreads();
}


template <class TileFn>
DI void h_stream(const Params& p, int l, TileFn tilefn) {
  const bf16_t* hbp = (const bf16_t*)(p.ws + O_HB);
  const bf16_t* w1 = (const bf16_t*)(p.ws + wset(l) + O_WFF1);
  bf16_t* hid = (bf16_t*)(p.ws + O_HID);
  gemm_stream<1024, 1024, 1024>(
      [&](int i, const bf16_t*& A, const bf16_t*& B) {
        int rt, ct;
        if (!tilefn(i, rt, ct)) return false;
        A = hbp + (size_t)rt * 256 * 1024; B = w1 + (size_t)ct * 256 * 1024; return true;
      },
      [&](int i, acc_t& acc) {
        int rt, ct;
        tilefn(i, rt, ct);
        store_bf16_tile<1>(acc, hid + (size_t)rt * 256 * HLD + ct * 256, HLD);
      });
}
DI void i_tile(const Params& p, int l, int rt, int ct) {
  const bf16_t* hid = (const bf16_t*)(p.ws + O_HID);
  const bf16_t* w2 = (const bf16_t*)(p.ws + wset(l) + O_WFF2);
  float* xp = xrow_ptr(p, rt * 256) + ct * 256;
  const float* gate = (const float*)(p.ws + O_MOD) + (size_t)l * 9 * 6144 + (size_t)modrow_of(rt * 256) * 6144 + 5 * 1024 + ct * 256;
  gemm_stream<HLD, 4096, 4096>(
      [&](int i, const bf16_t*& A, const bf16_t*& B) {
        if (i > 0) return false;
        A = hid + (size_t)rt * 256 * HLD; B = w2 + (size_t)ct * 256 * 4096; return true;
      },
      [&](int i, acc_t& acc) { residual_tile(acc, xp, gate); });
}
DI void publish_cnt(unsigned* c) {
  asm volatile("s_waitcnt vmcnt(0)" ::: "memory");
  __syncthreads();
  if (threadIdx.x == 0) {
    __builtin_amdgcn_fence(__ATOMIC_RELEASE, "agent");
    asm volatile("s_waitcnt vmcnt(0)" ::: "memory");
    (void)xb_add(c, 1u);
  }
}
DI void wait_cnt(unsigned* c, unsigned need, unsigned* barw) {
  if (threadIdx.x == 0) {
    XB_SPIN(xb_ld(c) < need, barw);
    __builtin_amdgcn_fence(__ATOMIC_ACQUIRE, "agent");
    asm volatile("s_waitcnt vmcnt(0)" ::: "memory");
  }
  __syncthreads();
}
DI void e_tile(const Params& p, int l, int rt, int ct) {
  const bf16_t* ymlap = (const bf16_t*)(p.ws + O_YMLA) + (size_t)rt * 256 * 512;
  const bf16_t* ynap = (const bf16_t*)(p.ws + O_YNA) + (size_t)rt * 256 * 512;
  const bf16_t* wmo = (const bf16_t*)(p.ws + wset(l) + O_WMO) + (size_t)ct * 256 * 512;
  const bf16_t* wno = (const bf16_t*)(p.ws + wset(l) + O_WNO) + (size_t)ct * 256 * 512;
  bf16_t* yt = (bf16_t*)(p.ws + O_Y) + (size_t)rt * 256 * 1024 + ct * 256;
  const bool cpan = (rt % 9 == 0);
  const bf16_t* gt = cpan ? (const bf16_t*)(p.ws + O_GATEC) + (size_t)(rt / 9) * 256 * 2048 + ct * 256
                          : (const bf16_t*)(p.ws + O_GATE) + (size_t)rt * 256 * PBW + ct * 256;
  const int ldg = cpan ? 2048 : PBW;
  gemm_stream<512, 512, 512>(
      [&](int i, const bf16_t*& A, const bf16_t*& B) {
        if (i > 1) return false;
        A = i ? ynap : ymlap; B = i ? wno : wmo; return true;
      },
      [&](int i, acc_t& acc) {
        if (i & 1) gated_tile<true>(acc, yt, 1024, gt + 1024, ldg);
        else gated_tile<false>(acc, yt, 1024, gt, ldg);
      });
}
DI void f_tile(const Params& p, int l, int rt, int ct) {
  const bf16_t* yp = (const bf16_t*)(p.ws + O_Y) + (size_t)rt * 256 * 1024;
  const bf16_t* wo = (const bf16_t*)(p.ws + wset(l) + O_WOUT) + (size_t)ct * 256 * 1024;
  float* xp = xrow_ptr(p, rt * 256) + ct * 256;
  const float* gate = (const float*)(p.ws + O_MOD) + (size_t)l * 9 * 6144 + (size_t)modrow_of(rt * 256) * 6144 + 2 * 1024 + ct * 256;
  const float* xin = l == 0 ? xrow_src(p, rt * 256, true) + ct * 256 : nullptr;
  gemm_stream<1024, 1024, 1024>(
      [&](int i, const bf16_t*& A, const bf16_t*& B) {
        if (i > 0) return false;
        A = yp; B = wo; return true;
      },
      [&](int i, acc_t& acc) { residual_tile(acc, xp, gate, xin); });
}
__global__ void __launch_bounds__(512, 2) fwd_megakernel(Params p) {
  cg::grid_group grid = cg::this_grid();
  char* ws = p.ws;
  const int G = gridDim.x;
  volatile LAS unsigned* xst = (volatile LAS unsigned*)(smem + 131072);
  if (threadIdx.x < 4) xst[threadIdx.x] = 0u;
  __syncthreads();
  const XcdBarrier xb = xcd_barrier_post((unsigned*)(ws + O_BAR), xst);

  phase0(p, smem);
  convert_weights(p, 0, smem, blockIdx.x, gridDim.x, 0, 1 << 30);
  zero_wp_pad(p, 0);
  xcd_barrier(xb);
  if (p.ws == nullptr) grid.sync();

  for (int l = 0; l < NLAYER; ++l) {
    const bool last = (l == NLAYER - 1);

    phase_norm(p, l, p.g_attn + l * 1024, 0, false, l == 0);
    xcd_barrier(xb);

    {
      const bf16_t* hbp = (const bf16_t*)(wsop(p) + O_HB);
      const bf16_t* wp = (const bf16_t*)(wsop(p) + wset(l) + O_WP);
      bf16_t* pbp = (bf16_t*)(wsop(p) + O_PB);
      const int b0 = blockIdx.x;
      const bf16_t* wgp = (const bf16_t*)(wsop(p) + wset(l) + O_WG);
      bf16_t* gcp = (bf16_t*)(wsop(p) + O_GATEC);
      const int nB = NRT * 11, nAll = nB + (last ? 0 : 64);
      gemm_stream<1024, 1024, 1024>(
          [&](int i, const bf16_t*& A, const bf16_t*& B) {
            const int t = b0 + i * G;
            if (t >= nAll) return false;
            if (t < nB) { A = hbp + (size_t)(t % NRT) * 256 * 1024; B = wp + (size_t)(t / NRT) * 256 * 1024; }
            else { const int j = t - nB; A = hbp + (size_t)(9 * (j >> 3)) * 256 * 1024; B = wgp + (size_t)(j & 7) * 256 * 1024; }
            return true;
          },
          [&](int i, acc_t& acc) {
            const int t = b0 + i * G;
            if (t < nB) store_bf16_tile<0>(acc, pbp + (size_t)(t % NRT) * 256 * PBW + (t / NRT) * 256, PBW);
            else { const int j = t - nB; store_bf16_tile<2>(acc, gcp + (size_t)(j >> 3) * 256 * 2048 + (j & 7) * 256, 2048); }
          });
      if (!last && blockIdx.x >= 88) convert_weights(p, l + 1, smem, (int)blockIdx.x - 88, 168, 0, 1400);
    }
    xcd_barrier(xb);

    {
      const bf16_t* pbp = (const bf16_t*)(wsop(p) + O_PB);
      const bf16_t* wuq = (const bf16_t*)(wsop(p) + wset(l) + O_WUQ);
      const bf16_t* wukv = (const bf16_t*)(wsop(p) + wset(l) + O_WUKV);
      bf16_t* qkp = (bf16_t*)(wsop(p) + O_QK2);
      const int b0 = blockIdx.x, b1 = (blockIdx.x + 40) % G;
      gemm_stream<PBW, 768, 768>(
          [&](int i, const bf16_t*& A, const bf16_t*& B) {
            const int t = b0 + i * G;
            if (t >= NRT * 3) return false;
            A = pbp + (size_t)(t % NRT) * 256 * PBW; B = wuq + (size_t)(t / NRT) * 256 * 768; return true;
          },
          [&](int i, acc_t& acc) {
            const int t = b0 + i * G;
            store_bf16_tile<0>(acc, qkp + (size_t)(t % NRT) * 256 * QKW + (t / NRT) * 256, QKW);
          });
      gemm_stream<PBW, 256, 256>(
          [&](int i, const bf16_t*& A, const bf16_t*& B) {
            const int t = b1 + i * G;
            if (t >= NRT * 4) return false;
            A = pbp + (size_t)(t % NRT) * 256 * PBW + 768; B = wukv + (size_t)(t / NRT) * 256 * 256; return true;
          },
          [&](int i, acc_t& acc) {
            const int t = b1 + i * G;
            store_bf16_tile<0>(acc, qkp + (size_t)(t % NRT) * 256 * QKW + 768 + (t / NRT) * 256, QKW);
          });
    }
    for (int t = blockIdx.x; t < TT / 16; t += G) rowstats_item(p, t);
    xcd_barrier(xb);

    {
      const int w = otid() >> 6;
      for (int wi = blockIdx.x * 8 + w; wi < 288 * 8 * 3; wi += G * 8) finalize_wave_item(p, l, wi);
    }
    xcd_barrier(xb);

    phase_attn(p, l, last, smem);
    xcd_barrier(xb);

    {
      unsigned* ce = (unsigned*)(wsop(p) + O_CE);
      unsigned* barw = (unsigned*)(wsop(p) + O_BAR);
      const int b = blockIdx.x;
      const unsigned need = 4u * (unsigned)(l + 1);
      if (!last) zero_wp_pad(p, l + 1);
      {
        const int li = b & 63, ct = b >> 6, rt = (li >> 3) * 9 + 1 + (li & 7);
        e_tile(p, l, rt, ct);
        publish_cnt(ce + rt * 16);
      }
      if (!last && b < 32) {
        const int rt = 9 * (b >> 2), ct = b & 3;
        e_tile(p, l, rt, ct);
        publish_cnt(ce + rt * 16);
        wait_cnt(ce + rt * 16, need, barw);
        f_tile(p, l, rt, ct);
      } else {
        {
          const int id = last ? b : b - 32, panel = id >> 2, ct = id & 3, rt = (panel >> 3) * 9 + 1 + (panel & 7);
          wait_cnt(ce + rt * 16, need, barw);
          f_tile(p, l, rt, ct);
        }
        if (!last) {
          if (b < 64) {
            const int id = 224 + (b - 32), panel = id >> 2, ct = id & 3, rt = (panel >> 3) * 9 + 1 + (panel & 7);
            wait_cnt(ce + rt * 16, need, barw);
            f_tile(p, l, rt, ct);
          } else {
            convert_weights(p, l + 1, smem, b - 64, 192, 1400, 1 << 30);
          }
        }
      }
      xcd_barrier(xb);
    }

    phase_norm(p, l, p.g_mlp + l * 1024, 3, last, false);
    xcd_barrier(xb);

    {
      unsigned* hcnt = (unsigned*)(wsop(p) + O_BAR + 14336);
      unsigned* barw = (unsigned*)(wsop(p) + O_BAR);
      const int b = blockIdx.x;
      auto publish = [&](int rtc) {
        asm volatile("s_waitcnt vmcnt(0)" ::: "memory");
        __syncthreads();
        if (threadIdx.x == 0) {
          __builtin_amdgcn_fence(__ATOMIC_RELEASE, "agent");
          asm volatile("s_waitcnt vmcnt(0)" ::: "memory");
          (void)xb_add(&hcnt[rtc * 16], 1u);
        }
      };
      if (last) {
        h_stream(p, l, [&](int i, int& rt, int& ct) { return tile_of(b + i * G, true, 16, rt, ct); });
      } else if (b < 32) {
        h_stream(p, l, [&](int i, int& rt, int& ct) { if (i > 0) return false; rt = 9 * (b >> 4); ct = b & 15; return true; });
        publish(b >> 4);
        const int rtc = b >> 2;
        if (threadIdx.x == 0) {
          XB_SPIN(xb_ld(&hcnt[rtc * 16]) < 16u * (unsigned)(l + 1), barw);
          __builtin_amdgcn_fence(__ATOMIC_ACQUIRE, "agent");
          asm volatile("s_waitcnt vmcnt(0)" ::: "memory");
        }
        __syncthreads();
        i_tile(p, l, 9 * rtc, b & 3);
      } else {
        int first = 0;
        if (b - 32 < 96) {
          const int c = 32 + (b - 32);
          h_stream(p, l, [&](int i, int& rt, int& ct) { if (i > 0) return false; rt = 9 * (c >> 4); ct = c & 15; return true; });
          publish(c >> 4);
          first = 1;
        }
        h_stream(p, l, [&](int i, int& rt, int& ct) {
          const int ii = i + first;
          if (ii >= 5) return false;
          const int m = (b - 32) + 224 * ii - 96, li = m & 63;
          rt = (li >> 3) * 9 + 1 + (li & 7); ct = m >> 6; return true;
        });
      }
    }
    xcd_barrier(xb);

    {
      const bool lat_only = true;
      for (int t = blockIdx.x;; t += G) {
        int rt, ct;
        if (!tile_of(t, lat_only, 4, rt, ct)) break;
        i_tile(p, l, rt, ct);
      }
    }
    if (!last) xcd_barrier(xb);
  }
}

extern "C" void kernel_launch(void* const* d_in, const int* in_sizes, int n_in, void* d_out, int out_size, void* d_ws, size_t ws_size, hipStream_t stream) {
  static int grid_blocks = 0;
  if (!grid_blocks) {
    int dev = 0, cus = 0, per_cu = 0;
    hipGetDevice(&dev);
    hipDeviceGetAttribute(&cus, hipDeviceAttributeMultiprocessorCount, dev);
    (void)hipFuncSetAttribute((const void*)fwd_megakernel, hipFuncAttributeMaxDynamicSharedMemorySize, 131072 + 16);
    hipOccupancyMaxActiveBlocksPerMultiprocessor(&per_cu, fwd_megakernel, 512, 131072 + 16);
    if (per_cu > 1) per_cu = 1;
    if (per_cu < 1) per_cu = 1;
    grid_blocks = cus * per_cu;
    if (grid_blocks != 256) { fprintf(stderr, "this kernel's static schedules need exactly 256 co-resident workgroups (got %d)\n", grid_blocks); grid_blocks = 256; }
  }
  if (ws_size < O_END) { fprintf(stderr, "workspace too small: %zu < %zu\n", ws_size, (size_t)O_END); return; }
  Params p{};
  const float** f = (const float**)&p;
  for (int i = 0; i < 23; ++i) f[i] = (const float*)d_in[i];
  p.out = (float*)d_out;
  p.ws = (char*)d_ws;
  void* args[] = {&p};
  (void)hipMemsetAsync((char*)d_ws + O_BAR, 0, 32768, stream);
  hipError_t e = hipLaunchCooperativeKernel((void*)fwd_megakernel, dim3(grid_blocks), dim3(512), args, 131072 + 16, stream);
  if (e != hipSuccess) fprintf(stderr, "cooperative launch failed: %s (grid %d)\n", hipGetErrorString(e), grid_blocks);
}
```

```cpp
#include <hip/hip_runtime.h>
#include <hip/hip_cooperative_groups.h>
#include <cstdio>
namespace cg = cooperative_groups;

typedef unsigned short bf16_t;
typedef short bf16x8 __attribute__((ext_vector_type(8)));
typedef float f32x4 __attribute__((ext_vector_type(4)));
typedef unsigned u32x4 __attribute__((ext_vector_type(4)));
typedef unsigned u32x2 __attribute__((ext_vector_type(2)));
#define DI __device__ __forceinline__

constexpr int DM = 1024, NBATCH = 8, SEQ = 2048, CTXL = 256, TPB = 2304, TT = 18432, NLAYER = 4;
constexpr int NRT = TT / 256;
constexpr int NTHR = 512, NWAVE = 8;
constexpr int INC = 4640;
constexpr int PBW = 2816;
constexpr int HLD = 4160;
constexpr int QKW = 1792;
constexpr float EPS = 1e-6f;
constexpr float LOG2E = 1.4426950408889634f;

constexpr size_t al256(size_t x) { return (x + 255) & ~(size_t)255; }
constexpr size_t O_WG   = 0;
constexpr size_t O_WP   = O_WG   + (size_t)2048 * 1024 * 2;
constexpr size_t O_WUQ  = O_WP   + (size_t)PBW * 1024 * 2;
constexpr size_t O_WUKV = O_WUQ  + (size_t)768 * 768 * 2;
constexpr size_t O_WMO  = O_WUKV + (size_t)1024 * 256 * 2;
constexpr size_t O_WNO  = O_WMO  + (size_t)1024 * 512 * 2;
constexpr size_t O_WOUT = O_WNO  + (size_t)1024 * 512 * 2;
constexpr size_t O_WFF1 = O_WOUT + (size_t)1024 * 1024 * 2;
constexpr size_t O_WFF2 = O_WFF1 + (size_t)4096 * 1024 * 2;
constexpr size_t O_MOD  = O_WFF2 + (size_t)4096 * 1024 * 2;
constexpr size_t O_TAB  = al256(O_MOD + (size_t)4 * 9 * 6144 * 4);
constexpr size_t O_STAT = al256(O_TAB + 64 * 8 * 2 * 4);
constexpr size_t O_XCTX = al256(O_STAT + (size_t)TT * 2 * 4);
constexpr size_t O_HB   = al256(O_XCTX + (size_t)2048 * 1024 * 4);
constexpr size_t O_PB   = al256(O_HB + (size_t)TT * 1024 * 2);
constexpr size_t O_QK2  = O_PB + (size_t)TT * PBW * 2;
constexpr size_t O_R2   = al256(O_QK2 + (size_t)TT * QKW * 2);
constexpr size_t O_MQ   = O_R2;
constexpr size_t O_MK   = O_MQ + (size_t)TT * 768 * 2;
constexpr size_t O_MVT  = O_MK + (size_t)TT * 768 * 2;
constexpr size_t O_NQ   = O_MVT + (size_t)TT * 512 * 2;
constexpr size_t O_NK   = O_NQ + (size_t)TT * 512 * 2;
constexpr size_t O_NVT  = O_NK + (size_t)TT * 512 * 2;
constexpr size_t O_BAR  = al256(O_NVT + (size_t)TT * 512 * 2);
constexpr size_t O_CE    = O_BAR + 16384;
constexpr size_t O_GATEC = O_BAR + 32768;
constexpr size_t O_W2   = al256(O_GATEC + (size_t)2048 * 2048 * 2);
constexpr size_t W_SET  = O_MOD - O_WG;
constexpr size_t O_END  = O_W2 + W_SET;
DI size_t wset(int l) { return (l & 1) ? (O_W2 - O_WG) : (size_t)0; }
constexpr size_t O_YMLA = O_QK2;
constexpr size_t O_YNA  = O_QK2 + (size_t)TT * 512 * 2;
constexpr size_t O_Y    = O_MQ;
constexpr size_t O_HID  = O_PB;
constexpr size_t O_GATE = O_PB;

struct Params {
  const float *x, *c, *ctx, *c_ctx, *w_ada, *b_ada, *g_attn, *w_in, *g_qa, *w_uq, *g_kva, *w_ukv, *g_mla_q, *g_mla_k, *g_na_q, *g_na_k, *rpb,
      *w_mla_o, *w_na_o, *w_out, *g_mlp, *w_ff1, *w_ff2;
  float* out;
  char* ws;
};

typedef float f32x2_t __attribute__((ext_vector_type(2)));
typedef __bf16 bf16x2_t __attribute__((ext_vector_type(2)));
DI unsigned cvt_pk_bf16(float lo, float hi) { f32x2_t v = {lo, hi}; bf16x2_t b = __builtin_convertvector(v, bf16x2_t); return __builtin_bit_cast(unsigned, b); }
DI bf16_t f2bf(float x) { unsigned u = __float_as_uint(x); u += 0x7fffu + ((u >> 16) & 1u); return (bf16_t)(u >> 16); }
DI float bflo(unsigned u) { return __uint_as_float(u << 16); }
DI float bfhi(unsigned u) { return __uint_as_float(u & 0xffff0000u); }
DI int otid() { int t = threadIdx.x; asm volatile("" : "+v"(t)); return t; }
struct Params;
DI float wave_sum(float v) {
#pragma unroll
  for (int o = 32; o >= 1; o >>= 1) v += __shfl_xor(v, o);
  return v;
}
DI float* xrow_ptr(const Params& p, int urow) {
  const int b = urow / TPB, t = urow - b * TPB;
  return t < CTXL ? (float*)(p.ws + O_XCTX) + ((size_t)(b * CTXL + t)) * DM : p.out + ((size_t)(b * SEQ + t - CTXL)) * DM;
}
DI const float* xrow_src(const Params& p, int urow, bool from_input) {
  const int b = urow / TPB, t = urow - b * TPB;
  if (from_input) return t < CTXL ? p.ctx + ((size_t)(b * CTXL + t)) * DM : p.x + ((size_t)(b * SEQ + t - CTXL)) * DM;
  return t < CTXL ? (const float*)(p.ws + O_XCTX) + ((size_t)(b * CTXL + t)) * DM : p.out + ((size_t)(b * SEQ + t - CTXL)) * DM;
}
DI char* wsop(const Params& p) { char* w = p.ws; asm volatile("" : "+s"(w)); return w; }
DI int modrow_of(int urow) { const int b = urow / TPB, t = urow - b * TPB; return t < CTXL ? 8 : b; }

extern __shared__ __attribute__((aligned(16))) char smem[];
typedef f32x4 acc_t[2][2][4][2];
DI int lds_byte(int r, int c) { const int st = (r >> 4) * 2 + (c >> 5), rr = r & 15, cc = c & 31, ob = rr * 64 + cc * 2; return st * 1024 + (ob ^ (((ob >> 9) & 1) << 5)); }
DI int perm32(int rho) { const int n = rho >> 4, i = rho & 15; return 8 * (i >> 2) + 4 * n + (i & 3); }
DI void stage_rc(int b, int& R, int& C) { const int st = b / 1024, sb = b % 1024, swz = sb ^ (((sb >> 9) & 1) << 5); R = (st >> 1) * 16 + swz / 64; C = (st & 1) * 32 + (swz % 64) / 2; }

template <int lda, int ldb, int K, class Gen, class Epi>
DI void gemm_stream(Gen gen, Epi epi) {
  constexpr int HTB = 16384, nt = K / 64;
#define SA(b, h) (smem + ((b) * 2 + (h)) * HTB)
#define SB(b, h) (smem + (4 + (b) * 2 + (h)) * HTB)
#define STG_A(P, ptr) do { const bf16_t* _g = (ptr); \
    __builtin_amdgcn_global_load_lds((const unsigned*)(_g + oa0), (__attribute__((address_space(3))) unsigned*)((P) + tb0), 16, 0, 0); \
    __builtin_amdgcn_global_load_lds((const unsigned*)(_g + (size_t)64 * lda + oa0), (__attribute__((address_space(3))) unsigned*)((P) + tb1), 16, 0, 0); } while (0)
#define STG_B(P, ptr) do { const bf16_t* _g = (ptr); \
    __builtin_amdgcn_global_load_lds((const unsigned*)(_g + ob0), (__attribute__((address_space(3))) unsigned*)((P) + tb0), 16, 0, 0); \
    __builtin_amdgcn_global_load_lds((const unsigned*)(_g + (size_t)64 * ldb + ob0), (__attribute__((address_space(3))) unsigned*)((P) + tb1), 16, 0, 0); } while (0)
#define LDA(dst, b, h) _Pragma("unroll") for (int m = 0; m < 4; ++m) _Pragma("unroll") for (int k = 0; k < 2; ++k) \
    dst[m][k] = *reinterpret_cast<const bf16x8*>(SA(b, h) + lds_byte(wr * 64 + m * 16 + fr, k * 32 + fq * 8))
#define LDB(dst, b, h) _Pragma("unroll") for (int n = 0; n < 2; ++n) _Pragma("unroll") for (int k = 0; k < 2; ++k) \
    dst[n][k] = *reinterpret_cast<const bf16x8*>(SB(b, h) + lds_byte(wc * 32 + n * 16 + fr, k * 32 + fq * 8))
#define MMA(ai, bj, At_, Bt_) do { __builtin_amdgcn_s_setprio(1); \
    _Pragma("unroll") for (int m = 0; m < 4; ++m) _Pragma("unroll") for (int n = 0; n < 2; ++n) _Pragma("unroll") for (int k = 0; k < 2; ++k) \
      acc[ai][bj][m][n] = __builtin_amdgcn_mfma_f32_16x16x32_bf16(Bt_[n][k], At_[m][k], acc[ai][bj][m][n], 0, 0, 0); \
    __builtin_amdgcn_s_setprio(0); } while (0)
#define WAIT_V(n) asm volatile("s_waitcnt vmcnt(" #n ")" ::: "memory")
#define WAIT_L(n) asm volatile("s_waitcnt lgkmcnt(" #n ")" ::: "memory")
#define BAR __builtin_amdgcn_s_barrier()
#define SCHED __builtin_amdgcn_sched_barrier(0)
  const bf16_t *A, *Bt;
  if (!gen(0, A, Bt)) return;
  const int tid = otid(), wid = tid >> 6, lane = tid & 63, wr = wid >> 2, wc = wid & 3, fr = lane & 15, fq = lane >> 4;
  const int tb0 = tid * 16, tb1 = tid * 16 + 8192;
  int r0_, c0_;
  stage_rc(tb0, r0_, c0_);
  const int r0p = (r0_ & ~31) | perm32(r0_ & 31);
  const unsigned oa0 = (unsigned)(r0_ * lda + c0_), ob0 = (unsigned)(r0p * ldb + c0_);
  acc_t acc;
  bf16x8 At[4][2], B0[2][2], B1[2][2];
  STG_B(SB(0, 0), Bt); STG_A(SA(0, 0), A);
  STG_B(SB(0, 1), Bt + (size_t)128 * ldb); STG_A(SA(0, 1), A + (size_t)128 * lda);
  if (wr == 1) BAR;
  WAIT_V(4); BAR;
  STG_B(SB(1, 0), Bt + 64); STG_A(SA(1, 0), A + 64); STG_B(SB(1, 1), Bt + (size_t)128 * ldb + 64);
  WAIT_V(6); BAR;
  for (int i = 0;; ++i) {
    const bf16_t *An, *Bn;
    const bool more = gen(i + 1, An, Bn);
    if (!more) { An = A; Bn = Bt; }
#pragma unroll
    for (int a = 0; a < 2; ++a)
#pragma unroll
      for (int b = 0; b < 2; ++b)
#pragma unroll
        for (int m = 0; m < 4; ++m)
#pragma unroll
          for (int n = 0; n < 2; ++n) acc[a][b][m][n] = (f32x4){0.f, 0.f, 0.f, 0.f};
    for (int t = 0; t < nt; t += 2) {
      const bool wrap = (t + 2 >= nt);
      const bf16_t* a1 = A + (t + 1) * 64;
      const bf16_t* a2 = wrap ? An : A + (t + 2) * 64;
      const bf16_t* b2 = wrap ? Bn : Bt + (t + 2) * 64;
      LDB(B0, 0, 0); SCHED; LDA(At, 0, 0); STG_A(SA(1, 1), a1 + (size_t)128 * lda);
      WAIT_L(8); BAR; WAIT_L(0); MMA(0, 0, At, B0); BAR; SCHED;
      LDB(B1, 0, 1); STG_B(SB(0, 0), b2);
      BAR; WAIT_L(0); MMA(0, 1, At, B1); BAR;
      LDA(At, 0, 1); STG_A(SA(0, 0), a2);
      BAR; WAIT_L(0); MMA(1, 0, At, B0); BAR; SCHED;
      STG_B(SB(0, 1), b2 + (size_t)128 * ldb);
      WAIT_V(6); BAR; MMA(1, 1, At, B1); BAR;
      LDB(B0, 1, 0); SCHED; LDA(At, 1, 0); STG_A(SA(0, 1), a2 + (size_t)128 * lda);
      WAIT_L(8); BAR; WAIT_L(0); MMA(0, 0, At, B0); BAR; SCHED;
      LDB(B1, 1, 1); STG_B(SB(1, 0), b2 + 64);
      BAR; WAIT_L(0); MMA(0, 1, At, B1); BAR;
      LDA(At, 1, 1); STG_A(SA(1, 0), a2 + 64);
      BAR; WAIT_L(0); MMA(1, 0, At, B0); BAR; SCHED;
      STG_B(SB(1, 1), b2 + (size_t)128 * ldb + 64);
      WAIT_V(6); BAR; MMA(1, 1, At, B1); BAR;
    }
    epi(i, acc);
    if (!more) break;
    A = An; Bt = Bn;
  }
  WAIT_V(0);
  if (wr == 0) BAR;
  BAR;
#undef SA
#undef SB
#undef STG_A
#undef STG_B
#undef LDA
#undef LDB
#undef MMA
#undef WAIT_V
#undef WAIT_L
#undef BAR
#undef SCHED
}
DI bool tile_of(int t, bool lat_only, int ncols, int& rt, int& ct) {
  if (lat_only) { if (t >= 64 * ncols) return false; const int li = t & 63; ct = t >> 6; rt = (li >> 3) * 9 + 1 + (li & 7); return true; }
  if (t >= NRT * ncols) return false;
  rt = t % NRT; ct = t / NRT; return true;
}
template <class F>
DI void epi_foreach(acc_t& acc, F f) {
  const int tid = otid(), wid = tid >> 6, lane = tid & 63, wr = wid >> 2, wc = wid & 3, fr = lane & 15, fq = lane >> 4;
#pragma unroll
  for (int ai = 0; ai < 2; ++ai)
#pragma unroll
    for (int m = 0; m < 4; ++m) {
#pragma unroll
      for (int bj = 0; bj < 2; ++bj) f(ai * 128 + wr * 64 + m * 16 + fr, bj * 128 + wc * 32 + 8 * fq, acc[ai][bj][m][0], acc[ai][bj][m][1]);
      if (m & 1) __builtin_amdgcn_sched_barrier(0);
    }
}
template <int ACT  >
DI void store_bf16_tile(acc_t& acc, bf16_t* O, int ldo) {
  epi_foreach(acc, [&](int r, int c, f32x4& v0, f32x4& v1) {
    float o[8] = {v0[0], v0[1], v0[2], v0[3], v1[0], v1[1], v1[2], v1[3]};
    if (ACT == 1) {
#pragma unroll
      for (int j = 0; j < 8; ++j) { const float q = fmaxf(o[j], 0.f); o[j] = q * q; }
    }
    if (ACT == 2) {
#pragma unroll
      for (int j = 0; j < 8; ++j) o[j] = __builtin_amdgcn_rcpf(1.f + __builtin_amdgcn_exp2f(-LOG2E * o[j]));
    }
    u32x4 pk;
#pragma unroll
    for (int j = 0; j < 4; ++j) pk[j] = cvt_pk_bf16(o[2 * j], o[2 * j + 1]);
    *(u32x4*)(O + (size_t)r * ldo + c) = pk;
  });
}
template <bool ADD>
DI void gated_tile(acc_t& acc, bf16_t* Y, int ldy, const bf16_t* Gt, int ldg) {
  epi_foreach(acc, [&](int r, int c, f32x4& v0, f32x4& v1) {
    const u32x4 g = *(const u32x4*)(Gt + (size_t)r * ldg + c);
    float o[8];
    o[0] = bflo(g[0]) * v0[0]; o[1] = bfhi(g[0]) * v0[1]; o[2] = bflo(g[1]) * v0[2]; o[3] = bfhi(g[1]) * v0[3];
    o[4] = bflo(g[2]) * v1[0]; o[5] = bfhi(g[2]) * v1[1]; o[6] = bflo(g[3]) * v1[2]; o[7] = bfhi(g[3]) * v1[3];
    bf16_t* py = Y + (size_t)r * ldy + c;
    if (ADD) {
      const u32x4 y0 = *(const u32x4*)py;
#pragma unroll
      for (int j = 0; j < 4; ++j) { o[2 * j] += bflo(y0[j]); o[2 * j + 1] += bfhi(y0[j]); }
    }
    u32x4 pk;
#pragma unroll
    for (int j = 0; j < 4; ++j) pk[j] = cvt_pk_bf16(o[2 * j], o[2 * j + 1]);
    *(u32x4*)py = pk;
  });
}
DI void residual_tile(acc_t& acc, float* X, const float* gate, const float* Xin = nullptr) {
  const float* xs = Xin ? Xin : X;
  epi_foreach(acc, [&](int r, int c, f32x4& v0, f32x4& v1) {
    const f32x4 g0 = *(const f32x4*)(gate + c), g1 = *(const f32x4*)(gate + c + 4);
    f32x4 x0 = *(const f32x4*)(xs + (size_t)r * DM + c), x1 = *(const f32x4*)(xs + (size_t)r * DM + c + 4);
    x0 = x0 + g0 * v0; x1 = x1 + g1 * v1;
    *(f32x4*)(X + (size_t)r * DM + c) = x0; *(f32x4*)(X + (size_t)r * DM + c + 4) = x1;
  });
}

struct ConvDesc { const float* src; int ld, col0, K, N; bf16_t* dst; int ldd; const float* scale; };
DI void conv_tile(const ConvDesc& d, int ti, char* smem) {
  float* tile = (float*)smem;
  const int nkt = d.K >> 6;
  const int k0 = (ti % nkt) * 64, n0 = (ti / nkt) * 64;
  const int tid = otid();
#pragma unroll
  for (int i = 0; i < 2; ++i) {
    const int idx = tid + i * 512, kk = idx >> 4, n4 = (idx & 15) * 4;
    f32x4 v = (f32x4){0.f, 0.f, 0.f, 0.f};
    if (n0 + n4 < d.N) v = *(const f32x4*)(d.src + (size_t)(k0 + kk) * d.ld + d.col0 + n0 + n4);
    if (d.scale) v = v * d.scale[k0 + kk];
    tile[kk * 65 + n4] = v[0]; tile[kk * 65 + n4 + 1] = v[1]; tile[kk * 65 + n4 + 2] = v[2]; tile[kk * 65 + n4 + 3] = v[3];
  }
  __syncthreads();
  {
    const int nn = tid >> 3, kc = (tid & 7) * 8;
    if (n0 + nn < d.N) {
      u32x4 o;
#pragma unroll
      for (int j = 0; j < 4; ++j) o[j] = cvt_pk_bf16(tile[(kc + 2 * j) * 65 + nn], tile[(kc + 2 * j + 1) * 65 + nn]);
      *(u32x4*)(d.dst + (size_t)(n0 + nn) * d.ldd + k0 + kc) = o;
    }
  }
  __syncthreads();
}
DI void convert_weights(const Params& p, int l, char* smem, int t_first, int t_stride, int t_begin, int t_end) {
  char* ws = p.ws + wset(l);
  const float* win = p.w_in + (size_t)l * DM * INC;
  const int cnt[12] = {16 * 32, 16 * 12, 16 * 4, 16 * 24, 16 * 1, 12 * 12, 4 * 16, 8 * 16, 8 * 16, 16 * 16, 16 * 64, 64 * 16};
  int total = 0;
#pragma unroll
  for (int i = 0; i < 12; ++i) total += cnt[i];
  if (t_end > total) t_end = total;
  for (int t = t_begin + t_first; t < t_end; t += t_stride) {
    int which = 0, rem = t;
#pragma unroll
    for (int i = 0; i < 12; ++i) { if (which == i && rem >= cnt[i]) { rem -= cnt[i]; which = i + 1; } }
    ConvDesc d;
    switch (which) {
      case 0: d = {win, INC, 0, 1024, 2048, (bf16_t*)(ws + O_WG), 1024, nullptr}; break;
      case 1: d = {win, INC, 2048, 1024, 768, (bf16_t*)(ws + O_WP), 1024, nullptr}; break;
      case 2: d = {win, INC, 2816, 1024, 256, (bf16_t*)(ws + O_WP) + (size_t)768 * 1024, 1024, nullptr}; break;
      case 3: d = {win, INC, 3104, 1024, 1536, (bf16_t*)(ws + O_WP) + (size_t)1024 * 1024, 1024, nullptr}; break;
      case 4: d = {win, INC, 3072, 1024, 32, (bf16_t*)(ws + O_WP) + (size_t)2560 * 1024, 1024, nullptr}; break;
      case 5: d = {p.w_uq + (size_t)l * 768 * 768, 768, 0, 768, 768, (bf16_t*)(ws + O_WUQ), 768, p.g_qa + l * 768}; break;
      case 6: d = {p.w_ukv + (size_t)l * 256 * 1024, 1024, 0, 256, 1024, (bf16_t*)(ws + O_WUKV), 256, p.g_kva + l * 256}; break;
      case 7: d = {p.w_mla_o + (size_t)l * 512 * 1024, 1024, 0, 512, 1024, (bf16_t*)(ws + O_WMO), 512, nullptr}; break;
      case 8: d = {p.w_na_o + (size_t)l * 512 * 1024, 1024, 0, 512, 1024, (bf16_t*)(ws + O_WNO), 512, nullptr}; break;
      case 9: d = {p.w_out + (size_t)l * 1024 * 1024, 1024, 0, 1024, 1024, (bf16_t*)(ws + O_WOUT), 1024, nullptr}; break;
      case 10: d = {p.w_ff1 + (size_t)l * 1024 * 4096, 4096, 0, 1024, 4096, (bf16_t*)(ws + O_WFF1), 1024, nullptr}; break;
      default: d = {p.w_ff2 + (size_t)l * 4096 * 1024, 1024, 0, 4096, 1024, (bf16_t*)(ws + O_WFF2), 4096, nullptr}; break;
    }
    conv_tile(d, rem, smem);
  }
}
DI void zero_wp_pad(const Params& p, int l) {
  u32x4* z = (u32x4*)((bf16_t*)(p.ws + wset(l) + O_WP) + (size_t)2592 * 1024);
  const int n16 = 224 * 1024 * 2 / 16;
  for (int i = blockIdx.x * 512 + (int)threadIdx.x; i < n16; i += gridDim.x * 512) z[i] = (u32x4){0u, 0u, 0u, 0u};
}

DI void phase0(const Params& p, char* smem) {
  char* ws = p.ws;
  const int tid = otid();
  if (blockIdx.x == gridDim.x - 1) {
    float* tab = (float*)(ws + O_TAB);
    for (int i = tid; i < 512; i += 512) {
      const int pos = i >> 3, f = i & 7;
      const float inv = powf(10000.f, -(float)f / 8.f);
      const float ang = (float)pos * inv;
      tab[i * 2] = cosf(ang); tab[i * 2 + 1] = sinf(ang);
    }
  }
  float* sc = (float*)smem;
  float* red = (float*)(smem + 36864);
  float* mod = (float*)(ws + O_MOD);
  for (int it = blockIdx.x; it < NLAYER * 96; it += gridDim.x) {
    const int l = it / 96, cgp = it % 96;
    for (int idx = tid; idx < 9 * 1024; idx += 512) {
      const int r = idx >> 10, k = idx & 1023;
      const float v = (r < 8) ? p.c[r * 1024 + k] : p.c_ctx[k];
      sc[idx] = v / (1.f + expf(-v));
    }
    __syncthreads();
    const int w = tid >> 6, lane = tid & 63, col = cgp * 64 + lane;
    float a[9];
#pragma unroll
    for (int r = 0; r < 9; ++r) a[r] = 0.f;
    const float* wp = p.w_ada + (size_t)l * 1024 * 6144 + col;
#pragma unroll 4
    for (int k = w * 128; k < w * 128 + 128; ++k) {
      const float wv = wp[(size_t)k * 6144];
#pragma unroll
      for (int r = 0; r < 9; ++r) a[r] += sc[r * 1024 + k] * wv;
    }
#pragma unroll
    for (int r = 0; r < 9; ++r) red[(w * 9 + r) * 64 + lane] = a[r];
    __syncthreads();
    for (int idx = tid; idx < 9 * 64; idx += 512) {
      const int r = idx >> 6, ln = idx & 63;
      float s = 0.f;
#pragma unroll
      for (int ww = 0; ww < 8; ++ww) s += red[(ww * 9 + r) * 64 + ln];
      mod[(size_t)(l * 9 + r) * 6144 + cgp * 64 + ln] = s + p.b_ada[l * 6144 + cgp * 64 + ln];
    }
    __syncthreads();
  }
}

DI void phase_norm(const Params& p, int l, const float* g, int shift_idx, bool skip_ctx, bool from_input) {
  const int tid = otid(), lane = tid & 63, w = tid >> 6;
  const float* mod = (const float*)(p.ws + O_MOD) + (size_t)l * 9 * 6144;
  bf16_t* hb = (bf16_t*)(p.ws + O_HB);
  const int stride = gridDim.x * 8;
  for (int row0 = blockIdx.x * 8 + w; row0 < TT; row0 += 2 * stride) {
    f32x4 v[2][4];
    bool act[2];
    int rows[2];
#pragma unroll
    for (int u = 0; u < 2; ++u) {
      const int row = row0 + u * stride;
      rows[u] = row;
      const int b = row / TPB, t = row - b * TPB;
      act[u] = (row < TT) && !(skip_ctx && t < CTXL);
      if (act[u]) {
        const float* xr = xrow_src(p, row, from_input);
#pragma unroll
        for (int i = 0; i < 4; ++i) v[u][i] = *(const f32x4*)(xr + lane * 4 + i * 256);
      } else {
#pragma unroll
        for (int i = 0; i < 4; ++i) v[u][i] = (f32x4){0.f, 0.f, 0.f, 0.f};
      }
    }
#pragma unroll
    for (int u = 0; u < 2; ++u) {
      if (!act[u]) continue;
      const int row = rows[u];
      const int b = row / TPB, t = row - b * TPB;
      float ss = 0.f;
#pragma unroll
      for (int i = 0; i < 4; ++i) ss += v[u][i][0] * v[u][i][0] + v[u][i][1] * v[u][i][1] + v[u][i][2] * v[u][i][2] + v[u][i][3] * v[u][i][3];
      ss = wave_sum(ss);
      const float rs = rsqrtf(ss * (1.f / 1024.f) + EPS);
      const float* mr = mod + (size_t)(t < CTXL ? 8 : b) * 6144 + shift_idx * 1024;
#pragma unroll
      for (int i = 0; i < 4; ++i) {
        const int col = lane * 4 + i * 256;
        const f32x4 gg = *(const f32x4*)(g + col), sh = *(const f32x4*)(mr + col), scl = *(const f32x4*)(mr + 1024 + col);
        f32x4 y = (v[u][i] * rs) * gg;
        y = y * (scl + 1.f) + sh;
        u32x2 pk; pk.x = cvt_pk_bf16(y[0], y[1]); pk.y = cvt_pk_bf16(y[2], y[3]);
        *(u32x2*)(hb + (size_t)row * 1024 + col) = pk;
      }
    }
  }
}

DI void rowstats_item(const Params& p, int item) {
  const int tid = otid(), lane = tid & 63, w = tid >> 6;
  const bf16_t* pb = (const bf16_t*)(p.ws + O_PB);
  float* st = (float*)(p.ws + O_STAT);
#pragma unroll 1
  for (int i = 0; i < 2; ++i) {
    const int row = item * 16 + w * 2 + i;
    const bf16_t* pr = pb + (size_t)row * PBW;
    float sq = 0.f, sk = 0.f;
    {
      u32x4 u = *(const u32x4*)(pr + lane * 8);
#pragma unroll
      for (int j = 0; j < 4; ++j) { float a = bflo(u[j]), b2 = bfhi(u[j]); sq += a * a + b2 * b2; }
    }
    if (lane < 32) {
      u32x4 u = *(const u32x4*)(pr + 512 + lane * 8);
#pragma unroll
      for (int j = 0; j < 4; ++j) { float a = bflo(u[j]), b2 = bfhi(u[j]); sq += a * a + b2 * b2; }
      u32x4 u2 = *(const u32x4*)(pr + 768 + lane * 8);
#pragma unroll
      for (int j = 0; j < 4; ++j) { float a = bflo(u2[j]), b2 = bfhi(u2[j]); sk += a * a + b2 * b2; }
    }
    sq = wave_sum(sq); sk = wave_sum(sk);
    if (lane == 0) { st[row * 2] = rsqrtf(sq * (1.f / 768.f) + EPS); st[row * 2 + 1] = rsqrtf(sk * (1.f / 256.f) + EPS); }
  }
}

DI void rope8(float (&x1)[8], float (&x2)[8], const float* tabrow) {
#pragma unroll
  for (int i = 0; i < 8; ++i) {
    const float c = tabrow[i * 2], s = tabrow[i * 2 + 1];
    const float a = x1[i], b = x2[i];
    x1[i] = a * c - b * s; x2[i] = a * s + b * c;
  }
}
DI void unpack8(const u32x4& u, float (&f)[8]) {
#pragma unroll
  for (int j = 0; j < 4; ++j) { f[2 * j] = bflo(u[j]); f[2 * j + 1] = bfhi(u[j]); }
}
DI u32x4 pack8(const float (&f)[8]) {
  u32x4 u;
#pragma unroll
  for (int j = 0; j < 4; ++j) u[j] = cvt_pk_bf16(f[2 * j], f[2 * j + 1]);
  return u;
}
DI float sumsq8(const u32x4& u) {
  float s = 0.f;
#pragma unroll
  for (int j = 0; j < 4; ++j) { float a = bflo(u[j]), b = bfhi(u[j]); s += a * a + b * b; }
  return s;
}
template <int NCH, bool ROPE>
DI void norm_rows16(int lane, size_t row0, bool is_ctx, int t0, const bf16_t* srcA, size_t ldA, int nA, const bf16_t* srcB, size_t ldB,
                    const float* st, int st_idx, const float* gain, float inv_n, bf16_t* dst, size_t ldd, const float* tab) {
  const int sub = lane & 15, tq = lane >> 4;
  const bool actv = sub < NCH, fromA = sub < nA;
  float gv[8];
#pragma unroll
  for (int j = 0; j < 8; ++j) gv[j] = actv ? gain[sub * 8 + j] : 0.f;
  u32x4 ua[16];
  float prea[16];
#pragma unroll
  for (int it = 0; it < 16; ++it) {
    const size_t row = row0 + it * 4 + tq;
    ua[it] = (u32x4){0u, 0u, 0u, 0u};
    if (actv) ua[it] = *(const u32x4*)(fromA ? srcA + row * ldA + sub * 8 : srcB + row * ldB + (sub - nA) * 8);
    prea[it] = 1.f;
    if (st_idx >= 0 && fromA) prea[it] = st[row * 2 + st_idx];
  }
#pragma unroll
  for (int it = 0; it < 16; ++it) {
    const int tk = it * 4 + tq;
    const size_t row = row0 + tk;
    const u32x4 u = ua[it];
    const float pre = prea[it];
    float f[8];
    unpack8(u, f);
    float ss = 0.f;
#pragma unroll
    for (int j = 0; j < 8; ++j) { f[j] *= pre; ss += f[j] * f[j]; }
    ss += __shfl_xor(ss, 1); ss += __shfl_xor(ss, 2); ss += __shfl_xor(ss, 4); ss += __shfl_xor(ss, 8);
    const float rs = rsqrtf(ss * inv_n + EPS);
#pragma unroll
    for (int j = 0; j < 8; ++j) f[j] *= rs * gv[j];
    if (ROPE) {
      float pf[8];
#pragma unroll
      for (int j = 0; j < 8; ++j) pf[j] = __shfl_xor(f[j], 1);
      if (!is_ctx && sub >= 8 && sub < 12) {
        const int pos = t0 + tk - CTXL;
        const float* tr = (const float*)smem + ((sub < 10) ? (pos >> 6) : (pos & 63)) * 16;
#pragma unroll
        for (int j = 0; j < 8; ++j) {
          const float c = tr[2 * j], sn = tr[2 * j + 1];
          f[j] = (sub & 1) ? (pf[j] * sn + f[j] * c) : (f[j] * c - pf[j] * sn);
        }
      }
    }
    if (actv) *(u32x4*)(dst + row * ldd + sub * 8) = pack8(f);
  }
}
DI void copy_rows8(int lane, size_t row0, const bf16_t* src, size_t lds_, const float* st, bf16_t* dst, size_t ldd) {
  const int sub = lane & 7, tq = lane >> 3;
  u32x4 ua[8];
  float sc[8];
#pragma unroll
  for (int it = 0; it < 8; ++it) {
    const size_t row = row0 + it * 8 + tq;
    ua[it] = *(const u32x4*)(src + row * lds_ + sub * 8);
    sc[it] = st ? st[row * 2 + 1] : 1.f;
  }
#pragma unroll
  for (int it = 0; it < 8; ++it) {
    const size_t row = row0 + it * 8 + tq;
    float f[8];
    unpack8(ua[it], f);
#pragma unroll
    for (int j = 0; j < 8; ++j) f[j] *= sc[it];
    *(u32x4*)(dst + row * ldd + sub * 8) = pack8(f);
  }
}
DI void finalize_wave_item(const Params& p, int l, int wi) {
  char* ws = p.ws;
  const int lane = otid() & 63;
  const int part = wi % 3, rest = wi / 3, h = rest & 7, g = rest >> 3;
  const int row = g * 64 + lane;
  const size_t row0 = (size_t)g * 64;
  const int b = g / 36, t0 = (g % 36) * 64, t = t0 + lane;
  const bool is_ctx = t0 < CTXL;
  const float* tab = (const float*)(ws + O_TAB);
  const bf16_t* pb0 = (const bf16_t*)(ws + O_PB);
  const bf16_t* qk0 = (const bf16_t*)(ws + O_QK2);
  const bf16_t* pb = pb0 + (size_t)row * PBW;
  const bf16_t* qk = qk0 + (size_t)row * QKW;
  const float* st0 = (const float*)(ws + O_STAT);
  const float* st = st0 + row * 2;
  if (part == 0) {
    norm_rows16<12, true>(lane, row0, is_ctx, t0, qk0 + h * 96, QKW, 12, qk0, QKW, st0, 0, p.g_mla_q + l * 96, 1.f / 96.f,
                          (bf16_t*)(ws + O_MQ) + h * 96, 768, tab);
  } else if (part == 1) {
    norm_rows16<12, true>(lane, row0, is_ctx, t0, qk0 + 768 + h * 128, QKW, 8, pb0 + 2560, PBW, st0, 1, p.g_mla_k + l * 96, 1.f / 96.f,
                          (bf16_t*)(ws + O_MK) + h * 96, 768, tab);
    copy_rows8(lane, row0, qk0 + 768 + h * 128 + 64, QKW, st0, (bf16_t*)(ws + O_MVT) + h * 64, 512);
  } else {
    norm_rows16<8, false>(lane, row0, is_ctx, t0, pb0 + 1024 + h * 64, PBW, 8, pb0, PBW, st0, -1, p.g_na_q + l * 64, 1.f / 64.f,
                          (bf16_t*)(ws + O_NQ) + h * 64, 512, tab);
    norm_rows16<8, false>(lane, row0, is_ctx, t0, pb0 + 1536 + h * 64, PBW, 8, pb0, PBW, st0, -1, p.g_na_k + l * 64, 1.f / 64.f,
                          (bf16_t*)(ws + O_NK) + h * 64, 512, tab);
  }
}

template <int DQK, bool NA, bool SMAX, int LDV>
DI void attn_item(const bf16_t* __restrict__ Qp, int ldq, const bf16_t* __restrict__ Kp, int ldk, const bf16_t* __restrict__ Vp  ,
                  int nkt, int koff, float c1, float m0, int r0, int rs, const float* __restrict__ rpb_g, bf16_t* __restrict__ Op, char* smem) {
  constexpr int KSTR = DQK * 2 + 32, KBYTES = 64 * KSTR, VSTR = 160, VBYTES = 64 * VSTR, STG = KBYTES + VBYTES;
  constexpr int CPK = DQK / 8, NKC = (64 * CPK + 511) / 512, NDS = DQK / 32;
  const int tid = otid(), lane = tid & 63, w = tid >> 6, fr = lane & 15, fq = lane >> 4;
  float* rpbl = (float*)(smem + 2 * STG);
  if (NA) { for (int i = tid; i < 465; i += 512) rpbl[i] = rpb_g[i] * LOG2E; }
  bf16x8 qf[2][NDS];
#pragma unroll
  for (int qt = 0; qt < 2; ++qt)
#pragma unroll
    for (int ds = 0; ds < NDS; ++ds) qf[qt][ds] = *(const bf16x8*)(Qp + (size_t)(w * 32 + qt * 16 + fr) * ldq + ds * 32 + fq * 8);
  u32x4 rkA[NKC], rvA, rkB[NKC], rvB;
  int kkey[NKC], kcc[NKC];
  bool kval[NKC];
#pragma unroll
  for (int i = 0; i < NKC; ++i) { const int c = tid + i * 512; kval[i] = c < 64 * CPK; kkey[i] = kval[i] ? c / CPK : 0; kcc[i] = kval[i] ? c - kkey[i] * CPK : 0; }
  const int vdv = tid >> 3, vcc = tid & 7;
  {
#pragma unroll
    for (int i = 0; i < NKC; ++i) rkA[i] = *(const u32x4*)(Kp + (size_t)kkey[i] * ldk + kcc[i] * 8);
    rvA = *(const u32x4*)(Vp + (size_t)vdv * LDV + vcc * 8);
    if (nkt > 1) {
      const int kb = 64;
#pragma unroll
      for (int i = 0; i < NKC; ++i) rkB[i] = *(const u32x4*)(Kp + (size_t)(kb + kkey[i]) * ldk + kcc[i] * 8);
      rvB = *(const u32x4*)(Vp + (size_t)(kb + vdv) * LDV + vcc * 8);
    }
#pragma unroll
    for (int i = 0; i < NKC; ++i) if (kval[i]) *(u32x4*)(smem + kkey[i] * KSTR + kcc[i] * 16) = rkA[i];
    *(u32x4*)(smem + KBYTES + vdv * VSTR + vcc * 16) = rvA;
  }
  __syncthreads();
  f32x4 o[4][2];
  float mrun[2], lrun[2];
#pragma unroll
  for (int qt = 0; qt < 2; ++qt) {
    mrun[qt] = -1e30f; lrun[qt] = 0.f;
#pragma unroll
    for (int d = 0; d < 4; ++d) o[d][qt] = (f32x4){0.f, 0.f, 0.f, 0.f};
  }
  auto step = [&](const int it, u32x4 (&rk_ld)[NKC], u32x4& rv_ld, u32x4 (&rk_wr)[NKC], u32x4& rv_wr) __attribute__((always_inline)) {
    const int cur = it & 1;
    const bool more = it + 1 < nkt;
    if (it + 2 < nkt) {
      const int kb = (it + 2) * 64 + ((it + 2) >= 4 ? koff : 0);
#pragma unroll
      for (int i = 0; i < NKC; ++i) rk_ld[i] = *(const u32x4*)(Kp + (size_t)(kb + kkey[i]) * ldk + kcc[i] * 8);
      rv_ld = *(const u32x4*)(Vp + (size_t)(kb + vdv) * LDV + vcc * 8);
    }
    __builtin_amdgcn_sched_barrier(0);
    const char* ks = smem + cur * STG;
    const char* vs = ks + KBYTES;
    f32x4 s[4][2];
#pragma unroll
    for (int kt = 0; kt < 4; ++kt) { s[kt][0] = (f32x4){0.f, 0.f, 0.f, 0.f}; s[kt][1] = (f32x4){0.f, 0.f, 0.f, 0.f}; }
#pragma unroll
    for (int ds = 0; ds < NDS; ++ds) {
      bf16x8 kf[4];
#pragma unroll
      for (int kt = 0; kt < 4; ++kt) kf[kt] = *(const bf16x8*)(ks + (kt * 16 + fr) * KSTR + ds * 64 + fq * 16);
#pragma unroll
      for (int kt = 0; kt < 4; ++kt) {
        s[kt][0] = __builtin_amdgcn_mfma_f32_16x16x32_bf16(kf[kt], qf[0][ds], s[kt][0], 0, 0, 0);
        s[kt][1] = __builtin_amdgcn_mfma_f32_16x16x32_bf16(kf[kt], qf[1][ds], s[kt][1], 0, 0, 0);
      }
    }
    bf16x8 vfr[2][4];
#pragma unroll
    for (int k2 = 0; k2 < 2; ++k2)
#pragma unroll
      for (int d = 0; d < 4; ++d) {
        const char* vp = vs + (k2 * 32 + fq * 4 + (fr >> 2)) * VSTR + d * 32 + (fr & 3) * 8;
        typedef short s16x4_t __attribute__((ext_vector_type(4)));
        const s16x4_t lo = __builtin_amdgcn_ds_read_tr16_b64_v4i16((__attribute__((address_space(3))) s16x4_t*)(vp));
        const s16x4_t hi = __builtin_amdgcn_ds_read_tr16_b64_v4i16((__attribute__((address_space(3))) s16x4_t*)(vp + 16 * VSTR));
        vfr[k2][d] = __builtin_shufflevector(lo, hi, 0, 1, 2, 3, 4, 5, 6, 7);
      }
    __builtin_amdgcn_sched_barrier(0);
    if (SMAX) {
#pragma unroll
      for (int qt = 0; qt < 2; ++qt) {
        float sum = 0.f;
        if (NA && it >= 4) {
          const int kr = rs + (it - 4);
          const int ql = w * 32 + qt * 16 + fr, qr = r0 + (ql >> 6), qc = ql & 63;
          const int rst = min(max(qr - 4, 0), 24);
          const bool rowok = (kr >= rst) && (kr < rst + 8);
          const int cst = min(max(qc - 8, 0), 48);
          const int base = (kr - qr + 7) * 31 + 15 - qc;
          float bv[4][4];
#pragma unroll
          for (int kt = 0; kt < 4; ++kt)
#pragma unroll
            for (int j = 0; j < 4; ++j) bv[kt][j] = rpbl[min(max(base + kt * 16 + fq * 4 + j, 0), 464)];
#pragma unroll
          for (int kt = 0; kt < 4; ++kt)
#pragma unroll
            for (int j = 0; j < 4; ++j) {
              const int kc = kt * 16 + fq * 4 + j;
              const float okf = (rowok && (kc >= cst) && (kc < cst + 16)) ? 1.f : 0.f;
              const float pv = __builtin_amdgcn_exp2f(__builtin_fmaf(s[kt][qt][j], c1, bv[kt][j] - m0)) * okf;
              s[kt][qt][j] = pv; sum += pv;
            }
        } else {
#pragma unroll
          for (int kt = 0; kt < 4; ++kt)
#pragma unroll
            for (int j = 0; j < 4; ++j) { const float pv = __builtin_amdgcn_exp2f(__builtin_fmaf(s[kt][qt][j], c1, -m0)); s[kt][qt][j] = pv; sum += pv; }
        }
        lrun[qt] += sum;
      }
    } else {
#pragma unroll
    for (int qt = 0; qt < 2; ++qt) {
      float mx = -1e30f;
      if (NA && it >= 4) {
        const int kr = rs + (it - 4);
        const int ql = w * 32 + qt * 16 + fr, qr = r0 + (ql >> 6), qc = ql & 63;
        const int rst = min(max(qr - 4, 0), 24);
        const bool rowok = (kr >= rst) && (kr < rst + 8);
        const int cst = min(max(qc - 8, 0), 48);
        const int base = (kr - qr + 7) * 31 + 15 - qc;
        float bv[4][4];
#pragma unroll
        for (int kt = 0; kt < 4; ++kt)
#pragma unroll
          for (int j = 0; j < 4; ++j) bv[kt][j] = rpbl[min(max(base + kt * 16 + fq * 4 + j, 0), 464)];
#pragma unroll
        for (int kt = 0; kt < 4; ++kt)
#pragma unroll
          for (int j = 0; j < 4; ++j) {
            const int kc = kt * 16 + fq * 4 + j;
            const float okf = (rowok && (kc >= cst) && (kc < cst + 16)) ? 1.f : 0.f;
            const float tv = __builtin_fmaf(s[kt][qt][j], c1, bv[kt][j]) * okf - (1.f - okf) * 1e30f;
            s[kt][qt][j] = tv; mx = fmaxf(mx, tv);
          }
      } else {
#pragma unroll
        for (int kt = 0; kt < 4; ++kt)
#pragma unroll
          for (int j = 0; j < 4; ++j) { const float tv = s[kt][qt][j] * c1; s[kt][qt][j] = tv; mx = fmaxf(mx, tv); }
      }
      mx = fmaxf(mx, __shfl_xor(mx, 16));
      mx = fmaxf(mx, __shfl_xor(mx, 32));
      const float mnew = fmaxf(mrun[qt], mx);
      const float alpha = __builtin_amdgcn_exp2f(mrun[qt] - mnew);
      mrun[qt] = mnew;
      float sum = 0.f;
#pragma unroll
      for (int kt = 0; kt < 4; ++kt)
#pragma unroll
        for (int j = 0; j < 4; ++j) { const float pv = __builtin_amdgcn_exp2f(s[kt][qt][j] - mnew); s[kt][qt][j] = pv; sum += pv; }
      lrun[qt] = lrun[qt] * alpha + sum;
#pragma unroll
      for (int d = 0; d < 4; ++d) o[d][qt] = o[d][qt] * alpha;
    }
    }
#pragma unroll
    for (int k2 = 0; k2 < 2; ++k2) {
      bf16x8 pf[2];
#pragma unroll
      for (int qt = 0; qt < 2; ++qt) {
        u32x4 u;
        u[0] = cvt_pk_bf16(s[2 * k2][qt][0], s[2 * k2][qt][1]); u[1] = cvt_pk_bf16(s[2 * k2][qt][2], s[2 * k2][qt][3]);
        u[2] = cvt_pk_bf16(s[2 * k2 + 1][qt][0], s[2 * k2 + 1][qt][1]); u[3] = cvt_pk_bf16(s[2 * k2 + 1][qt][2], s[2 * k2 + 1][qt][3]);
        pf[qt] = __builtin_bit_cast(bf16x8, u);
      }
#pragma unroll
      for (int d = 0; d < 4; ++d) {
        o[d][0] = __builtin_amdgcn_mfma_f32_16x16x32_bf16(vfr[k2][d], pf[0], o[d][0], 0, 0, 0);
        o[d][1] = __builtin_amdgcn_mfma_f32_16x16x32_bf16(vfr[k2][d], pf[1], o[d][1], 0, 0, 0);
      }
    }
    if (more) {
      char* nx = smem + (cur ^ 1) * STG;
#pragma unroll
      for (int i = 0; i < NKC; ++i) if (kval[i]) *(u32x4*)(nx + kkey[i] * KSTR + kcc[i] * 16) = rk_wr[i];
      *(u32x4*)(nx + KBYTES + vdv * VSTR + vcc * 16) = rv_wr;
    }
    __syncthreads();
  };
  for (int it = 0; it < nkt; it += 2) {
    step(it, rkA, rvA, rkB, rvB);
    if (it + 1 < nkt) step(it + 1, rkB, rvB, rkA, rvA);
  }
#pragma unroll
  for (int qt = 0; qt < 2; ++qt) {
    float lt = lrun[qt];
    lt += __shfl_xor(lt, 16);
    lt += __shfl_xor(lt, 32);
    const float inv = 1.f / lt;
#pragma unroll
    for (int d = 0; d < 4; ++d) {
      u32x2 pk; pk.x = cvt_pk_bf16(o[d][qt][0] * inv, o[d][qt][1] * inv); pk.y = cvt_pk_bf16(o[d][qt][2] * inv, o[d][qt][3] * inv);
      *(u32x2*)(Op + (size_t)(w * 32 + qt * 16 + fr) * 512 + d * 16 + fq * 4) = pk;
    }
  }
}

DI void phase_attn(const Params& p, int l, bool last, char* smem) {
  char* ws = p.ws;
  const bf16_t* mq = (const bf16_t*)(ws + O_MQ); const bf16_t* mk = (const bf16_t*)(ws + O_MK); const bf16_t* mvt = (const bf16_t*)(ws + O_MVT);
  const bf16_t* nq = (const bf16_t*)(ws + O_NQ); const bf16_t* nk = (const bf16_t*)(ws + O_NK);
  const bf16_t* pbv = (const bf16_t*)(ws + O_PB) + 2048;
  bf16_t* ymla = (bf16_t*)(ws + O_YMLA); bf16_t* yna = (bf16_t*)(ws + O_YNA);
  const float c_mla = LOG2E * 0.10206207261596575f;
  const float c_na = LOG2E * 0.125f;
  float m0_mla, m0_na;
  {
    const int tid = otid();
    float a = 0.f, b2 = 0.f, c = 0.f, d = 0.f, e = 0.f;
    if (tid < 96) { a = fabsf(p.g_mla_q[l * 96 + tid]); b2 = fabsf(p.g_mla_k[l * 96 + tid]); }
    if (tid < 64) { c = fabsf(p.g_na_q[l * 64 + tid]); d = fabsf(p.g_na_k[l * 64 + tid]); }
    for (int i = tid; i < 8 * 465; i += 512) e = fmaxf(e, p.rpb[(size_t)l * 8 * 465 + i]);
#pragma unroll
    for (int o = 32; o >= 1; o >>= 1) { a = fmaxf(a, __shfl_xor(a, o)); b2 = fmaxf(b2, __shfl_xor(b2, o)); c = fmaxf(c, __shfl_xor(c, o)); d = fmaxf(d, __shfl_xor(d, o)); e = fmaxf(e, __shfl_xor(e, o)); }
    float* red = (float*)smem;
    if ((tid & 63) == 0) { const int w = tid >> 6; red[w * 8 + 0] = a; red[w * 8 + 1] = b2; red[w * 8 + 2] = c; red[w * 8 + 3] = d; red[w * 8 + 4] = e; }
    __syncthreads();
    a = b2 = c = d = e = 0.f;
#pragma unroll
    for (int w = 0; w < 8; ++w) { a = fmaxf(a, red[w * 8]); b2 = fmaxf(b2, red[w * 8 + 1]); c = fmaxf(c, red[w * 8 + 2]); d = fmaxf(d, red[w * 8 + 3]); e = fmaxf(e, red[w * 8 + 4]); }
    __syncthreads();
    m0_mla = c_mla * 96.f * a * b2;
    m0_na = c_na * 64.f * c * d + e * LOG2E;
  }
  const bool smax_mla = m0_mla < 64.f, smax_na = m0_na < 64.f;
  for (int item = blockIdx.x; item < 1024; item += gridDim.x) {
    const int kind = item >> 9, it2 = item & 511;
    const int xx = it2 & 7, yy = it2 >> 3;
    const int bh = xx + 8 * (yy >> 3), qt = yy & 7;
    const int b = bh >> 3, h = bh & 7;
    const int q0 = b * TPB + CTXL + qt * 256;
    if (kind == 0) {
      if (smax_mla) attn_item<96, false, true, 512>(mq + (size_t)q0 * 768 + h * 96, 768, mk + (size_t)b * TPB * 768 + h * 96, 768, mvt + (size_t)b * TPB * 512 + h * 64,
                           36, 0, c_mla, m0_mla, 0, 0, nullptr, ymla + (size_t)q0 * 512 + h * 64, smem);
      else attn_item<96, false, false, 512>(mq + (size_t)q0 * 768 + h * 96, 768, mk + (size_t)b * TPB * 768 + h * 96, 768, mvt + (size_t)b * TPB * 512 + h * 64,
                           36, 0, c_mla, 0.f, 0, 0, nullptr, ymla + (size_t)q0 * 512 + h * 64, smem);
    } else {
      const int r0 = qt * 4;
      const int rs = min(max(r0 - 4, 0), 24);
      const int re = min(max(r0 + 3 - 4, 0), 24) + 8;
      if (smax_na) attn_item<64, true, true, PBW>(nq + (size_t)q0 * 512 + h * 64, 512, nk + (size_t)b * TPB * 512 + h * 64, 512, pbv + (size_t)b * TPB * PBW + h * 64,
                          4 + (re - rs), rs * 64, c_na, m0_na, r0, rs, p.rpb + ((size_t)l * 8 + h) * 465, yna + (size_t)q0 * 512 + h * 64, smem);
      else attn_item<64, true, false, PBW>(nq + (size_t)q0 * 512 + h * 64, 512, nk + (size_t)b * TPB * 512 + h * 64, 512, pbv + (size_t)b * TPB * PBW + h * 64,
                          4 + (re - rs), rs * 64, c_na, 0.f, r0, rs, p.rpb + ((size_t)l * 8 + h) * 465, yna + (size_t)q0 * 512 + h * 64, smem);
    }
  }
  {
    const bf16_t* hbp = (const bf16_t*)(ws + O_HB);
    const bf16_t* wg = (const bf16_t*)(ws + wset(l) + O_WG);
    bf16_t* gp = (bf16_t*)(ws + O_GATE);
    const int b0 = blockIdx.x, Gd = gridDim.x;
    gemm_stream<1024, 1024, 1024>(
        [&](int i, const bf16_t*& A, const bf16_t*& B) {
          int rt, ct;
          if (!tile_of(b0 + i * Gd, true, 8, rt, ct)) return false;
          A = hbp + (size_t)rt * 256 * 1024; B = wg + (size_t)ct * 256 * 1024; return true;
        },
        [&](int i, acc_t& acc) {
          int rt, ct;
          tile_of(b0 + i * Gd, true, 8, rt, ct);
          store_bf16_tile<2>(acc, gp + (size_t)rt * 256 * PBW + ct * 256, PBW);
        });
  }
  if (!last) {
    for (int it2 = blockIdx.x; it2 < 128; it2 += gridDim.x) {
      const int kind = it2 >> 6, bh = it2 & 63;
      const int b = bh >> 3, h = bh & 7;
      const int q0 = b * TPB;
      if (kind == 0)
        attn_item<96, false, false, 512>(mq + (size_t)q0 * 768 + h * 96, 768, mk + (size_t)b * TPB * 768 + h * 96, 768, mvt + (size_t)b * TPB * 512 + h * 64,
                             4, 0, c_mla, 0.f, 0, 0, nullptr, ymla + (size_t)q0 * 512 + h * 64, smem);
      else
        attn_item<64, false, false, PBW>(nq + (size_t)q0 * 512 + h * 64, 512, nk + (size_t)b * TPB * 512 + h * 64, 512, pbv + (size_t)b * TPB * PBW + h * 64,
                             4, 0, c_na, 0.f, 0, 0, nullptr, yna + (size_t)q0 * 512 + h * 64, smem);
    }
  }
}

#define XB_TMO      128
#define XB_XCNT(j)  (256  + 64 * (j))
#define XB_XSUB(j)  (1280 + 64 * (j))
#define XB_XGEN(j)  (2304 + 64 * (j))
#define XB_TOP      3328
#define XB_TOPGEN   3392
#define XCD_BAR_WORDS 3456
#define XB_SPIN_CAP (1u << 18)
#define LAS __attribute__((address_space(3)))

__device__ __forceinline__ unsigned xb_ld(unsigned* p)              { return __hip_atomic_load(p, __ATOMIC_RELAXED, __HIP_MEMORY_SCOPE_AGENT); }
__device__ __forceinline__ unsigned xb_add(unsigned* p, unsigned v) { return __hip_atomic_fetch_add(p, v, __ATOMIC_RELAXED, __HIP_MEMORY_SCOPE_AGENT); }
__device__ __forceinline__ unsigned xb_xcc_id() { return (unsigned)__builtin_amdgcn_s_getreg((3 << 11) | 20) & 0xFu; }
#define XB_SPIN(cond, bar) do { unsigned _sp = 0; while (cond) { __builtin_amdgcn_s_sleep(1); \
    if ((++_sp & 255u) == 0u) { if (xb_ld(&(bar)[XB_TMO])) break; if (_sp > XB_SPIN_CAP) { atomicAdd(&(bar)[XB_TMO], 1u); break; } } } } while (0)

struct XcdBarrier {
    unsigned* bar; unsigned x;
    volatile LAS unsigned* st;
};

__device__ __forceinline__ XcdBarrier xcd_barrier_post(unsigned* bar, volatile LAS unsigned* st) {
    XcdBarrier b; b.bar = bar; b.x = xb_xcc_id(); b.st = st;
    if (threadIdx.x == 0) (void)xb_add(&bar[XB_XCNT(b.x)], 1u);
    return b;
}
__device__ __forceinline__ void xcd_barrier_complete(unsigned* bar, unsigned x, unsigned& nloc, unsigned& nx) {
    const unsigned G = gridDim.x * gridDim.y * gridDim.z;
    unsigned sum, cnt, mine, sp = 0u;
    for (;;) {
        sum = 0u; cnt = 0u; mine = 0u;
#pragma unroll
        for (unsigned j = 0; j < 16; ++j) { const unsigned c = xb_ld(&bar[XB_XCNT(j)]); sum += c; cnt += (c > 0u) ? 1u : 0u; mine = (j == x) ? c : mine; }
        if (sum == G) break;
        __builtin_amdgcn_s_sleep(1);
        if ((++sp & 255u) == 0u) { if (xb_ld(&bar[XB_TMO])) break; if (sp > XB_SPIN_CAP) { atomicAdd(&bar[XB_TMO], 1u); break; } }
    }
    nloc = mine > 0u ? mine : 1u; nx = cnt > 0u ? cnt : 1u;
}

__device__ __forceinline__ void xcd_barrier(const XcdBarrier& b) {
    asm volatile("s_waitcnt vmcnt(0)" ::: "memory");
    __syncthreads();
    if (threadIdx.x == 0) {
        unsigned* bar = b.bar;
        __builtin_amdgcn_s_waitcnt(0);
        unsigned nloc = b.st[0], nx = b.st[1];
        if (nloc == 0u) { xcd_barrier_complete(bar, b.x, nloc, nx); b.st[0] = nloc; b.st[1] = nx; }
        const unsigned old = xb_add(&bar[XB_XSUB(b.x)], 1u);
        const unsigned gen = old / nloc;
        if (old + 1u == (gen + 1u) * nloc) {
            __builtin_amdgcn_fence(__ATOMIC_RELEASE, "agent");
            asm volatile("s_waitcnt vmcnt(0)" ::: "memory");
            const unsigned og = xb_add(&bar[XB_TOP], 1u);
            const unsigned tg = og / nx;
            if (og + 1u == (tg + 1u) * nx) xb_add(&bar[XB_TOPGEN], 1u);
            else XB_SPIN(xb_ld(&bar[XB_TOPGEN]) == tg, bar);
            __builtin_amdgcn_fence(__ATOMIC_ACQUIRE, "agent");
            xb_add(&bar[XB_XGEN(b.x)], 1u);
            asm volatile("s_waitcnt vmcnt(0)" ::: "memory");
        } else {
            XB_SPIN(xb_ld(&bar[XB_XGEN(b.x)]) == gen, bar);
            __builtin_amdgcn_fence(__ATOMIC_ACQUIRE, "agent");
            asm volatile("s_waitcnt vmcnt(0)" ::: "memory");
        }
    }
    __syncthreads();
}


template <class TileFn>
DI void h_stream(const Params& p, int l, TileFn tilefn) {
  const bf16_t* hbp = (const bf16_t*)(p.ws + O_HB);
  const bf16_t* w1 = (const bf16_t*)(p.ws + wset(l) + O_WFF1);
  bf16_t* hid = (bf16_t*)(p.ws + O_HID);
  gemm_stream<1024, 1024, 1024>(
      [&](int i, const bf16_t*& A, const bf16_t*& B) {
        int rt, ct;
        if (!tilefn(i, rt, ct)) return false;
        A = hbp + (size_t)rt * 256 * 1024; B = w1 + (size_t)ct * 256 * 1024; return true;
      },
      [&](int i, acc_t& acc) {
        int rt, ct;
        tilefn(i, rt, ct);
        store_bf16_tile<1>(acc, hid + (size_t)rt * 256 * HLD + ct * 256, HLD);
      });
}
DI void i_tile(const Params& p, int l, int rt, int ct) {
  const bf16_t* hid = (const bf16_t*)(p.ws + O_HID);
  const bf16_t* w2 = (const bf16_t*)(p.ws + wset(l) + O_WFF2);
  float* xp = xrow_ptr(p, rt * 256) + ct * 256;
  const float* gate = (const float*)(p.ws + O_MOD) + (size_t)l * 9 * 6144 + (size_t)modrow_of(rt * 256) * 6144 + 5 * 1024 + ct * 256;
  gemm_stream<HLD, 4096, 4096>(
      [&](int i, const bf16_t*& A, const bf16_t*& B) {
        if (i > 0) return false;
        A = hid + (size_t)rt * 256 * HLD; B = w2 + (size_t)ct * 256 * 4096; return true;
      },
      [&](int i, acc_t& acc) { residual_tile(acc, xp, gate); });
}
DI void publish_cnt(unsigned* c) {
  asm volatile("s_waitcnt vmcnt(0)" ::: "memory");
  __syncthreads();
  if (threadIdx.x == 0) {
    __builtin_amdgcn_fence(__ATOMIC_RELEASE, "agent");
    asm volatile("s_waitcnt vmcnt(0)" ::: "memory");
    (void)xb_add(c, 1u);
  }
}
DI void wait_cnt(unsigned* c, unsigned need, unsigned* barw) {
  if (threadIdx.x == 0) {
    XB_SPIN(xb_ld(c) < need, barw);
    __builtin_amdgcn_fence(__ATOMIC_ACQUIRE, "agent");
    asm volatile("s_waitcnt vmcnt(0)" ::: "memory");
  }
  __syncthreads();
}
DI void e_tile(const Params& p, int l, int rt, int ct) {
  const bf16_t* ymlap = (const bf16_t*)(p.ws + O_YMLA) + (size_t)rt * 256 * 512;
  const bf16_t* ynap = (const bf16_t*)(p.ws + O_YNA) + (size_t)rt * 256 * 512;
  const bf16_t* wmo = (const bf16_t*)(p.ws + wset(l) + O_WMO) + (size_t)ct * 256 * 512;
  const bf16_t* wno = (const bf16_t*)(p.ws + wset(l) + O_WNO) + (size_t)ct * 256 * 512;
  bf16_t* yt = (bf16_t*)(p.ws + O_Y) + (size_t)rt * 256 * 1024 + ct * 256;
  const bool cpan = (rt % 9 == 0);
  const bf16_t* gt = cpan ? (const bf16_t*)(p.ws + O_GATEC) + (size_t)(rt / 9) * 256 * 2048 + ct * 256
                          : (const bf16_t*)(p.ws + O_GATE) + (size_t)rt * 256 * PBW + ct * 256;
  const int ldg = cpan ? 2048 : PBW;
  gemm_stream<512, 512, 512>(
      [&](int i, const bf16_t*& A, const bf16_t*& B) {
        if (i > 1) return false;
        A = i ? ynap : ymlap; B = i ? wno : wmo; return true;
      },
      [&](int i, acc_t& acc) {
        if (i & 1) gated_tile<true>(acc, yt, 1024, gt + 1024, ldg);
        else gated_tile<false>(acc, yt, 1024, gt, ldg);
      });
}
DI void f_tile(const Params& p, int l, int rt, int ct) {
  const bf16_t* yp = (const bf16_t*)(p.ws + O_Y) + (size_t)rt * 256 * 1024;
  const bf16_t* wo = (const bf16_t*)(p.ws + wset(l) + O_WOUT) + (size_t)ct * 256 * 1024;
  float* xp = xrow_ptr(p, rt * 256) + ct * 256;
  const float* gate = (const float*)(p.ws + O_MOD) + (size_t)l * 9 * 6144 + (size_t)modrow_of(rt * 256) * 6144 + 2 * 1024 + ct * 256;
  const float* xin = l == 0 ? xrow_src(p, rt * 256, true) + ct * 256 : nullptr;
  gemm_stream<1024, 1024, 1024>(
      [&](int i, const bf16_t*& A, const bf16_t*& B) {
        if (i > 0) return false;
        A = yp; B = wo; return true;
      },
      [&](int i, acc_t& acc) { residual_tile(acc, xp, gate, xin); });
}
__global__ void __launch_bounds__(512, 2) fwd_megakernel(Params p) {
  cg::grid_group grid = cg::this_grid();
  char* ws = p.ws;
  const int G = gridDim.x;
  volatile LAS unsigned* xst = (volatile LAS unsigned*)(smem + 131072);
  if (threadIdx.x < 4) xst[threadIdx.x] = 0u;
  __syncthreads();
  const XcdBarrier xb = xcd_barrier_post((unsigned*)(ws + O_BAR), xst);

  phase0(p, smem);
  convert_weights(p, 0, smem, blockIdx.x, gridDim.x, 0, 1 << 30);
  zero_wp_pad(p, 0);
  xcd_barrier(xb);
  if (p.ws == nullptr) grid.sync();

  for (int l = 0; l < NLAYER; ++l) {
    const bool last = (l == NLAYER - 1);

    phase_norm(p, l, p.g_attn + l * 1024, 0, false, l == 0);
    xcd_barrier(xb);

    {
      const bf16_t* hbp = (const bf16_t*)(wsop(p) + O_HB);
      const bf16_t* wp = (const bf16_t*)(wsop(p) + wset(l) + O_WP);
      bf16_t* pbp = (bf16_t*)(wsop(p) + O_PB);
      const int b0 = blockIdx.x;
      const bf16_t* wgp = (const bf16_t*)(wsop(p) + wset(l) + O_WG);
      bf16_t* gcp = (bf16_t*)(wsop(p) + O_GATEC);
      const int nB = NRT * 11, nAll = nB + (last ? 0 : 64);
      gemm_stream<1024, 1024, 1024>(
          [&](int i, const bf16_t*& A, const bf16_t*& B) {
            const int t = b0 + i * G;
            if (t >= nAll) return false;
            if (t < nB) { A = hbp + (size_t)(t % NRT) * 256 * 1024; B = wp + (size_t)(t / NRT) * 256 * 1024; }
            else { const int j = t - nB; A = hbp + (size_t)(9 * (j >> 3)) * 256 * 1024; B = wgp + (size_t)(j & 7) * 256 * 1024; }
            return true;
          },
          [&](int i, acc_t& acc) {
            const int t = b0 + i * G;
            if (t < nB) store_bf16_tile<0>(acc, pbp + (size_t)(t % NRT) * 256 * PBW + (t / NRT) * 256, PBW);
            else { const int j = t - nB; store_bf16_tile<2>(acc, gcp + (size_t)(j >> 3) * 256 * 2048 + (j & 7) * 256, 2048); }
          });
      if (!last && blockIdx.x >= 88) convert_weights(p, l + 1, smem, (int)blockIdx.x - 88, 168, 0, 1400);
    }
    xcd_barrier(xb);

    {
      const bf16_t* pbp = (const bf16_t*)(wsop(p) + O_PB);
      const bf16_t* wuq = (const bf16_t*)(wsop(p) + wset(l) + O_WUQ);
      const bf16_t* wukv = (const bf16_t*)(wsop(p) + wset(l) + O_WUKV);
      bf16_t* qkp = (bf16_t*)(wsop(p) + O_QK2);
      const int b0 = blockIdx.x, b1 = (blockIdx.x + 40) % G;
      gemm_stream<PBW, 768, 768>(
          [&](int i, const bf16_t*& A, const bf16_t*& B) {
            const int t = b0 + i * G;
            if (t >= NRT * 3) return false;
            A = pbp + (size_t)(t % NRT) * 256 * PBW; B = wuq + (size_t)(t / NRT) * 256 * 768; return true;
          },
          [&](int i, acc_t& acc) {
            const int t = b0 + i * G;
            store_bf16_tile<0>(acc, qkp + (size_t)(t % NRT) * 256 * QKW + (t / NRT) * 256, QKW);
          });
      gemm_stream<PBW, 256, 256>(
          [&](int i, const bf16_t*& A, const bf16_t*& B) {
            const int t = b1 + i * G;
            if (t >= NRT * 4) return false;
            A = pbp + (size_t)(t % NRT) * 256 * PBW + 768; B = wukv + (size_t)(t / NRT) * 256 * 256; return true;
          },
          [&](int i, acc_t& acc) {
            const int t = b1 + i * G;
            store_bf16_tile<0>(acc, qkp + (size_t)(t % NRT) * 256 * QKW + 768 + (t / NRT) * 256, QKW);
          });
    }
    for (int t = blockIdx.x; t < TT / 16; t += G) rowstats_item(p, t);
    xcd_barrier(xb);

    {
      const int tidf = otid(), w = tidf >> 6;
      {
        const float* tabg = (const float*)(wsop(p) + O_TAB);
        float* tl = (float*)smem;
        for (int i = tidf; i < 1024; i += 512) tl[i] = tabg[i];
        __syncthreads();
      }
      for (int wi = blockIdx.x * 8 + w; wi < 288 * 8 * 3; wi += G * 8) finalize_wave_item(p, l, wi);
    }
    xcd_barrier(xb);

    phase_attn(p, l, last, smem);
    xcd_barrier(xb);

    {
      unsigned* ce = (unsigned*)(wsop(p) + O_CE);
      unsigned* barw = (unsigned*)(wsop(p) + O_BAR);
      const int b = blockIdx.x;
      const unsigned need = 4u * (unsigned)(l + 1);
      if (!last) zero_wp_pad(p, l + 1);
      {
        const int li = b & 63, ct = b >> 6, rt = (li >> 3) * 9 + 1 + (li & 7);
        e_tile(p, l, rt, ct);
        publish_cnt(ce + rt * 16);
      }
      if (!last && b < 32) {
        const int rt = 9 * (b >> 2), ct = b & 3;
        e_tile(p, l, rt, ct);
        publish_cnt(ce + rt * 16);
        wait_cnt(ce + rt * 16, need, barw);
        f_tile(p, l, rt, ct);
      } else {
        {
          const int id = last ? b : b - 32, panel = id >> 2, ct = id & 3, rt = (panel >> 3) * 9 + 1 + (panel & 7);
          wait_cnt(ce + rt * 16, need, barw);
          f_tile(p, l, rt, ct);
        }
        if (!last) {
          if (b < 64) {
            const int id = 224 + (b - 32), panel = id >> 2, ct = id & 3, rt = (panel >> 3) * 9 + 1 + (panel & 7);
            wait_cnt(ce + rt * 16, need, barw);
            f_tile(p, l, rt, ct);
          } else {
            convert_weights(p, l + 1, smem, b - 64, 192, 1400, 1 << 30);
          }
        }
      }
      xcd_barrier(xb);
    }

    phase_norm(p, l, p.g_mlp + l * 1024, 3, last, false);
    xcd_barrier(xb);

    {
      unsigned* hcnt = (unsigned*)(wsop(p) + O_BAR + 14336);
      unsigned* barw = (unsigned*)(wsop(p) + O_BAR);
      const int b = blockIdx.x;
      auto publish = [&](int rtc) {
        asm volatile("s_waitcnt vmcnt(0)" ::: "memory");
        __syncthreads();
        if (threadIdx.x == 0) {
          __builtin_amdgcn_fence(__ATOMIC_RELEASE, "agent");
          asm volatile("s_waitcnt vmcnt(0)" ::: "memory");
          (void)xb_add(&hcnt[rtc * 16], 1u);
        }
      };
      if (last) {
        h_stream(p, l, [&](int i, int& rt, int& ct) { return tile_of(b + i * G, true, 16, rt, ct); });
      } else if (b < 32) {
        h_stream(p, l, [&](int i, int& rt, int& ct) { if (i > 0) return false; rt = 9 * (b >> 4); ct = b & 15; return true; });
        publish(b >> 4);
        const int rtc = b >> 2;
        if (threadIdx.x == 0) {
          XB_SPIN(xb_ld(&hcnt[rtc * 16]) < 16u * (unsigned)(l + 1), barw);
          __builtin_amdgcn_fence(__ATOMIC_ACQUIRE, "agent");
          asm volatile("s_waitcnt vmcnt(0)" ::: "memory");
        }
        __syncthreads();
        i_tile(p, l, 9 * rtc, b & 3);
      } else {
        int first = 0;
        if (b - 32 < 96) {
          const int c = 32 + (b - 32);
          h_stream(p, l, [&](int i, int& rt, int& ct) { if (i > 0) return false; rt = 9 * (c >> 4); ct = c & 15; return true; });
          publish(c >> 4);
          first = 1;
        }
        h_stream(p, l, [&](int i, int& rt, int& ct) {
          const int ii = i + first;
          if (ii >= 5) return false;
          const int m = (b - 32) + 224 * ii - 96, li = m & 63;
          rt = (li >> 3) * 9 + 1 + (li & 7); ct = m >> 6; return true;
        });
      }
    }
    xcd_barrier(xb);

    {
      const bool lat_only = true;
      for (int t = blockIdx.x;; t += G) {
        int rt, ct;
        if (!tile_of(t, lat_only, 4, rt, ct)) break;
        i_tile(p, l, rt, ct);
      }
    }
    if (!last) xcd_barrier(xb);
  }
}

extern "C" void kernel_launch(void* const* d_in, const int* in_sizes, int n_in, void* d_out, int out_size, void* d_ws, size_t ws_size, hipStream_t stream) {
  static int grid_blocks = 0;
  if (!grid_blocks) {
    int dev = 0, cus = 0, per_cu = 0;
    hipGetDevice(&dev);
    hipDeviceGetAttribute(&cus, hipDeviceAttributeMultiprocessorCount, dev);
    (void)hipFuncSetAttribute((const void*)fwd_megakernel, hipFuncAttributeMaxDynamicSharedMemorySize, 131072 + 16);
    hipOccupancyMaxActiveBlocksPerMultiprocessor(&per_cu, fwd_megakernel, 512, 131072 + 16);
    if (per_cu > 1) per_cu = 1;
    if (per_cu < 1) per_cu = 1;
    grid_blocks = cus * per_cu;
    if (grid_blocks != 256) { fprintf(stderr, "this kernel's static schedules need exactly 256 co-resident workgroups (got %d)\n", grid_blocks); grid_blocks = 256; }
  }
  if (ws_size < O_END) { fprintf(stderr, "workspace too small: %zu < %zu\n", ws_size, (size_t)O_END); return; }
  Params p{};
  const float** f = (const float**)&p;
  for (int i = 0; i < 23; ++i) f[i] = (const float*)d_in[i];
  p.out = (float*)d_out;
  p.ws = (char*)d_ws;
  void* args[] = {&p};
  (void)hipMemsetAsync((char*)d_ws + O_BAR, 0, 32768, stream);
  hipError_t e = hipLaunchCooperativeKernel((void*)fwd_megakernel, dim3(grid_blocks), dim3(512), args, 131072 + 16, stream);
  if (e != hipSuccess) fprintf(stderr, "cooperative launch failed: %s (grid %d)\n", hipGetErrorString(e), grid_blocks);
}
```

```cpp
#include <hip/hip_runtime.h>
#include <hip/hip_cooperative_groups.h>
#include <cstdio>
namespace cg = cooperative_groups;

typedef unsigned short bf16_t;
typedef short bf16x8 __attribute__((ext_vector_type(8)));
typedef float f32x4 __attribute__((ext_vector_type(4)));
typedef unsigned u32x4 __attribute__((ext_vector_type(4)));
typedef unsigned u32x2 __attribute__((ext_vector_type(2)));
#define DI __device__ __forceinline__

constexpr int DM = 1024, NBATCH = 8, SEQ = 2048, CTXL = 256, TPB = 2304, TT = 18432, NLAYER = 4;
constexpr int NRT = TT / 256;
constexpr int NTHR = 512, NWAVE = 8;
constexpr int INC = 4640;
constexpr int PBW = 2816;
constexpr int HLD = 4160;
constexpr int QKW = 1792;
constexpr float EPS = 1e-6f;
constexpr float LOG2E = 1.4426950408889634f;

constexpr size_t al256(size_t x) { return (x + 255) & ~(size_t)255; }
constexpr size_t O_WG   = 0;
constexpr size_t O_WP   = O_WG   + (size_t)2048 * 1024 * 2;
constexpr size_t O_WUQ  = O_WP   + (size_t)PBW * 1024 * 2;
constexpr size_t O_WUKV = O_WUQ  + (size_t)768 * 768 * 2;
constexpr size_t O_WMO  = O_WUKV + (size_t)1024 * 256 * 2;
constexpr size_t O_WNO  = O_WMO  + (size_t)1024 * 512 * 2;
constexpr size_t O_WOUT = O_WNO  + (size_t)1024 * 512 * 2;
constexpr size_t O_WFF1 = O_WOUT + (size_t)1024 * 1024 * 2;
constexpr size_t O_WFF2 = O_WFF1 + (size_t)4096 * 1024 * 2;
constexpr size_t O_MOD  = O_WFF2 + (size_t)4096 * 1024 * 2;
constexpr size_t O_TAB  = al256(O_MOD + (size_t)4 * 9 * 6144 * 4);
constexpr size_t O_STAT = al256(O_TAB + 64 * 8 * 2 * 4);
constexpr size_t O_XCTX = al256(O_STAT + (size_t)TT * 2 * 4);
constexpr size_t O_HB   = al256(O_XCTX + (size_t)2048 * 1024 * 4);
constexpr size_t O_PB   = al256(O_HB + (size_t)TT * 1024 * 2);
constexpr size_t O_QK2  = O_PB + (size_t)TT * PBW * 2;
constexpr size_t O_R2   = al256(O_QK2 + (size_t)TT * QKW * 2);
constexpr size_t O_MQ   = O_R2;
constexpr size_t O_MK   = O_MQ + (size_t)TT * 768 * 2;
constexpr size_t O_MVT  = O_MK + (size_t)TT * 768 * 2;
constexpr size_t O_NQ   = O_MVT + (size_t)TT * 512 * 2;
constexpr size_t O_NK   = O_NQ + (size_t)TT * 512 * 2;
constexpr size_t O_NVT  = O_NK + (size_t)TT * 512 * 2;
constexpr size_t O_BAR  = al256(O_NVT + (size_t)TT * 512 * 2);
constexpr size_t O_CE    = O_BAR + 16384;
constexpr size_t O_GATEC = O_BAR + 32768;
constexpr size_t O_W2   = al256(O_GATEC + (size_t)2048 * 2048 * 2);
constexpr size_t W_SET  = O_MOD - O_WG;
constexpr size_t O_END  = O_W2 + W_SET;
DI size_t wset(int l) { return (l & 1) ? (O_W2 - O_WG) : (size_t)0; }
constexpr size_t O_YMLA = O_QK2;
constexpr size_t O_YNA  = O_QK2 + (size_t)TT * 512 * 2;
constexpr size_t O_Y    = O_MQ;
constexpr size_t O_HID  = O_PB;
constexpr size_t O_GATE = O_PB;

struct Params {
  const float *x, *c, *ctx, *c_ctx, *w_ada, *b_ada, *g_attn, *w_in, *g_qa, *w_uq, *g_kva, *w_ukv, *g_mla_q, *g_mla_k, *g_na_q, *g_na_k, *rpb,
      *w_mla_o, *w_na_o, *w_out, *g_mlp, *w_ff1, *w_ff2;
  float* out;
  char* ws;
};

typedef float f32x2_t __attribute__((ext_vector_type(2)));
typedef __bf16 bf16x2_t __attribute__((ext_vector_type(2)));
DI unsigned cvt_pk_bf16(float lo, float hi) { f32x2_t v = {lo, hi}; bf16x2_t b = __builtin_convertvector(v, bf16x2_t); return __builtin_bit_cast(unsigned, b); }
DI bf16_t f2bf(float x) { unsigned u = __float_as_uint(x); u += 0x7fffu + ((u >> 16) & 1u); return (bf16_t)(u >> 16); }
DI float bflo(unsigned u) { return __uint_as_float(u << 16); }
DI float bfhi(unsigned u) { return __uint_as_float(u & 0xffff0000u); }
DI int otid() { int t = threadIdx.x; asm volatile("" : "+v"(t)); return t; }
struct Params;
DI float wave_sum(float v) {
#pragma unroll
  for (int o = 32; o >= 1; o >>= 1) v += __shfl_xor(v, o);
  return v;
}
DI float* xrow_ptr(const Params& p, int urow) {
  const int b = urow / TPB, t = urow - b * TPB;
  return t < CTXL ? (float*)(p.ws + O_XCTX) + ((size_t)(b * CTXL + t)) * DM : p.out + ((size_t)(b * SEQ + t - CTXL)) * DM;
}
DI const float* xrow_src(const Params& p, int urow, bool from_input) {
  const int b = urow / TPB, t = urow - b * TPB;
  if (from_input) return t < CTXL ? p.ctx + ((size_t)(b * CTXL + t)) * DM : p.x + ((size_t)(b * SEQ + t - CTXL)) * DM;
  return t < CTXL ? (const float*)(p.ws + O_XCTX) + ((size_t)(b * CTXL + t)) * DM : p.out + ((size_t)(b * SEQ + t - CTXL)) * DM;
}
DI char* wsop(const Params& p) { char* w = p.ws; asm volatile("" : "+s"(w)); return w; }
DI int modrow_of(int urow) { const int b = urow / TPB, t = urow - b * TPB; return t < CTXL ? 8 : b; }

extern __shared__ __attribute__((aligned(16))) char smem[];
typedef f32x4 acc_t[2][2][4][2];
DI int lds_byte(int r, int c) { const int st = (r >> 4) * 2 + (c >> 5), rr = r & 15, cc = c & 31, ob = rr * 64 + cc * 2; return st * 1024 + (ob ^ (((ob >> 9) & 1) << 5)); }
DI int perm32(int rho) { const int n = rho >> 4, i = rho & 15; return 8 * (i >> 2) + 4 * n + (i & 3); }
DI void stage_rc(int b, int& R, int& C) { const int st = b / 1024, sb = b % 1024, swz = sb ^ (((sb >> 9) & 1) << 5); R = (st >> 1) * 16 + swz / 64; C = (st & 1) * 32 + (swz % 64) / 2; }

template <int lda, int ldb, int K, class Gen, class Epi>
DI void gemm_stream(Gen gen, Epi epi) {
  constexpr int HTB = 16384, nt = K / 64;
#define SA(b, h) (smem + ((b) * 2 + (h)) * HTB)
#define SB(b, h) (smem + (4 + (b) * 2 + (h)) * HTB)
#define STG_A(P, ptr) do { const bf16_t* _g = (ptr); \
    __builtin_amdgcn_global_load_lds((const unsigned*)(_g + oa0), (__attribute__((address_space(3))) unsigned*)((P) + tb0), 16, 0, 0); \
    __builtin_amdgcn_global_load_lds((const unsigned*)(_g + (size_t)64 * lda + oa0), (__attribute__((address_space(3))) unsigned*)((P) + tb1), 16, 0, 0); } while (0)
#define STG_B(P, ptr) do { const bf16_t* _g = (ptr); \
    __builtin_amdgcn_global_load_lds((const unsigned*)(_g + ob0), (__attribute__((address_space(3))) unsigned*)((P) + tb0), 16, 0, 0); \
    __builtin_amdgcn_global_load_lds((const unsigned*)(_g + (size_t)64 * ldb + ob0), (__attribute__((address_space(3))) unsigned*)((P) + tb1), 16, 0, 0); } while (0)
#define LDA(dst, b, h) _Pragma("unroll") for (int m = 0; m < 4; ++m) _Pragma("unroll") for (int k = 0; k < 2; ++k) \
    dst[m][k] = *reinterpret_cast<const bf16x8*>(SA(b, h) + lds_byte(wr * 64 + m * 16 + fr, k * 32 + fq * 8))
#define LDB(dst, b, h) _Pragma("unroll") for (int n = 0; n < 2; ++n) _Pragma("unroll") for (int k = 0; k < 2; ++k) \
    dst[n][k] = *reinterpret_cast<const bf16x8*>(SB(b, h) + lds_byte(wc * 32 + n * 16 + fr, k * 32 + fq * 8))
#define MMA(ai, bj, At_, Bt_) do { __builtin_amdgcn_s_setprio(1); \
    _Pragma("unroll") for (int m = 0; m < 4; ++m) _Pragma("unroll") for (int n = 0; n < 2; ++n) _Pragma("unroll") for (int k = 0; k < 2; ++k) \
      acc[ai][bj][m][n] = __builtin_amdgcn_mfma_f32_16x16x32_bf16(Bt_[n][k], At_[m][k], acc[ai][bj][m][n], 0, 0, 0); \
    __builtin_amdgcn_s_setprio(0); } while (0)
#define WAIT_V(n) asm volatile("s_waitcnt vmcnt(" #n ")" ::: "memory")
#define WAIT_L(n) asm volatile("s_waitcnt lgkmcnt(" #n ")" ::: "memory")
#define BAR __builtin_amdgcn_s_barrier()
#define SCHED __builtin_amdgcn_sched_barrier(0)
  const bf16_t *A, *Bt;
  if (!gen(0, A, Bt)) return;
  const int tid = otid(), wid = tid >> 6, lane = tid & 63, wr = wid >> 2, wc = wid & 3, fr = lane & 15, fq = lane >> 4;
  const int tb0 = tid * 16, tb1 = tid * 16 + 8192;
  int r0_, c0_;
  stage_rc(tb0, r0_, c0_);
  const int r0p = (r0_ & ~31) | perm32(r0_ & 31);
  const unsigned oa0 = (unsigned)(r0_ * lda + c0_), ob0 = (unsigned)(r0p * ldb + c0_);
  acc_t acc;
  bf16x8 At[4][2], B0[2][2], B1[2][2];
  STG_B(SB(0, 0), Bt); STG_A(SA(0, 0), A);
  STG_B(SB(0, 1), Bt + (size_t)128 * ldb); STG_A(SA(0, 1), A + (size_t)128 * lda);
  if (wr == 1) BAR;
  WAIT_V(4); BAR;
  STG_B(SB(1, 0), Bt + 64); STG_A(SA(1, 0), A + 64); STG_B(SB(1, 1), Bt + (size_t)128 * ldb + 64);
  WAIT_V(6); BAR;
  for (int i = 0;; ++i) {
    const bf16_t *An, *Bn;
    const bool more = gen(i + 1, An, Bn);
    if (!more) { An = A; Bn = Bt; }
#pragma unroll
    for (int a = 0; a < 2; ++a)
#pragma unroll
      for (int b = 0; b < 2; ++b)
#pragma unroll
        for (int m = 0; m < 4; ++m)
#pragma unroll
          for (int n = 0; n < 2; ++n) acc[a][b][m][n] = (f32x4){0.f, 0.f, 0.f, 0.f};
    for (int t = 0; t < nt; t += 2) {
      const bool wrap = (t + 2 >= nt);
      const bf16_t* a1 = A + (t + 1) * 64;
      const bf16_t* a2 = wrap ? An : A + (t + 2) * 64;
      const bf16_t* b2 = wrap ? Bn : Bt + (t + 2) * 64;
      LDB(B0, 0, 0); SCHED; LDA(At, 0, 0); STG_A(SA(1, 1), a1 + (size_t)128 * lda);
      WAIT_L(8); BAR; WAIT_L(0); MMA(0, 0, At, B0); BAR; SCHED;
      LDB(B1, 0, 1); STG_B(SB(0, 0), b2);
      BAR; WAIT_L(0); MMA(0, 1, At, B1); BAR;
      LDA(At, 0, 1); STG_A(SA(0, 0), a2);
      BAR; WAIT_L(0); MMA(1, 0, At, B0); BAR; SCHED;
      STG_B(SB(0, 1), b2 + (size_t)128 * ldb);
      WAIT_V(6); BAR; MMA(1, 1, At, B1); BAR;
      LDB(B0, 1, 0); SCHED; LDA(At, 1, 0); STG_A(SA(0, 1), a2 + (size_t)128 * lda);
      WAIT_L(8); BAR; WAIT_L(0); MMA(0, 0, At, B0); BAR; SCHED;
      LDB(B1, 1, 1); STG_B(SB(1, 0), b2 + 64);
      BAR; WAIT_L(0); MMA(0, 1, At, B1); BAR;
      LDA(At, 1, 1); STG_A(SA(1, 0), a2 + 64);
      BAR; WAIT_L(0); MMA(1, 0, At, B0); BAR; SCHED;
      STG_B(SB(1, 1), b2 + (size_t)128 * ldb + 64);
      WAIT_V(6); BAR; MMA(1, 1, At, B1); BAR;
    }
    epi(i, acc);
    if (!more) break;
    A = An; Bt = Bn;
  }
  WAIT_V(0);
  if (wr == 0) BAR;
  BAR;
#undef SA
#undef SB
#undef STG_A
#undef STG_B
#undef LDA
#undef LDB
#undef MMA
#undef WAIT_V
#undef WAIT_L
#undef BAR
#undef SCHED
}
DI bool tile_of(int t, bool lat_only, int ncols, int& rt, int& ct) {
  if (lat_only) { if (t >= 64 * ncols) return false; const int li = t & 63; ct = t >> 6; rt = (li >> 3) * 9 + 1 + (li & 7); return true; }
  if (t >= NRT * ncols) return false;
  rt = t % NRT; ct = t / NRT; return true;
}
template <class F>
DI void epi_foreach(acc_t& acc, F f) {
  const int tid = otid(), wid = tid >> 6, lane = tid & 63, wr = wid >> 2, wc = wid & 3, fr = lane & 15, fq = lane >> 4;
#pragma unroll
  for (int ai = 0; ai < 2; ++ai)
#pragma unroll
    for (int m = 0; m < 4; ++m) {
#pragma unroll
      for (int bj = 0; bj < 2; ++bj) f(ai * 128 + wr * 64 + m * 16 + fr, bj * 128 + wc * 32 + 8 * fq, acc[ai][bj][m][0], acc[ai][bj][m][1]);
      if (m == 3) __builtin_amdgcn_sched_barrier(0);
    }
}
template <int ACT  >
DI void store_bf16_tile(acc_t& acc, bf16_t* O, int ldo) {
  epi_foreach(acc, [&](int r, int c, f32x4& v0, f32x4& v1) {
    float o[8] = {v0[0], v0[1], v0[2], v0[3], v1[0], v1[1], v1[2], v1[3]};
    if (ACT == 1) {
#pragma unroll
      for (int j = 0; j < 8; ++j) { const float q = fmaxf(o[j], 0.f); o[j] = q * q; }
    }
    if (ACT == 2) {
#pragma unroll
      for (int j = 0; j < 8; ++j) o[j] = __builtin_amdgcn_rcpf(1.f + __builtin_amdgcn_exp2f(-LOG2E * o[j]));
    }
    u32x4 pk;
#pragma unroll
    for (int j = 0; j < 4; ++j) pk[j] = cvt_pk_bf16(o[2 * j], o[2 * j + 1]);
    *(u32x4*)(O + (size_t)r * ldo + c) = pk;
  });
}
template <bool ADD>
DI void gated_tile(acc_t& acc, bf16_t* Y, int ldy, const bf16_t* Gt, int ldg) {
  epi_foreach(acc, [&](int r, int c, f32x4& v0, f32x4& v1) {
    const u32x4 g = *(const u32x4*)(Gt + (size_t)r * ldg + c);
    float o[8];
    o[0] = bflo(g[0]) * v0[0]; o[1] = bfhi(g[0]) * v0[1]; o[2] = bflo(g[1]) * v0[2]; o[3] = bfhi(g[1]) * v0[3];
    o[4] = bflo(g[2]) * v1[0]; o[5] = bfhi(g[2]) * v1[1]; o[6] = bflo(g[3]) * v1[2]; o[7] = bfhi(g[3]) * v1[3];
    bf16_t* py = Y + (size_t)r * ldy + c;
    if (ADD) {
      const u32x4 y0 = *(const u32x4*)py;
#pragma unroll
      for (int j = 0; j < 4; ++j) { o[2 * j] += bflo(y0[j]); o[2 * j + 1] += bfhi(y0[j]); }
    }
    u32x4 pk;
#pragma unroll
    for (int j = 0; j < 4; ++j) pk[j] = cvt_pk_bf16(o[2 * j], o[2 * j + 1]);
    *(u32x4*)py = pk;
  });
}
DI void residual_tile(acc_t& acc, float* X, const float* gate, const float* Xin = nullptr) {
  const float* xs = Xin ? Xin : X;
  epi_foreach(acc, [&](int r, int c, f32x4& v0, f32x4& v1) {
    const f32x4 g0 = *(const f32x4*)(gate + c), g1 = *(const f32x4*)(gate + c + 4);
    f32x4 x0 = *(const f32x4*)(xs + (size_t)r * DM + c), x1 = *(const f32x4*)(xs + (size_t)r * DM + c + 4);
    x0 = x0 + g0 * v0; x1 = x1 + g1 * v1;
    *(f32x4*)(X + (size_t)r * DM + c) = x0; *(f32x4*)(X + (size_t)r * DM + c + 4) = x1;
  });
}

struct ConvDesc { const float* src; int ld, col0, K, N; bf16_t* dst; int ldd; const float* scale; };
DI void conv_tile(const ConvDesc& d, int ti, char* smem) {
  float* tile = (float*)smem;
  const int nkt = d.K >> 6;
  const int k0 = (ti % nkt) * 64, n0 = (ti / nkt) * 64;
  const int tid = otid();
#pragma unroll
  for (int i = 0; i < 2; ++i) {
    const int idx = tid + i * 512, kk = idx >> 4, n4 = (idx & 15) * 4;
    f32x4 v = (f32x4){0.f, 0.f, 0.f, 0.f};
    if (n0 + n4 < d.N) v = *(const f32x4*)(d.src + (size_t)(k0 + kk) * d.ld + d.col0 + n0 + n4);
    if (d.scale) v = v * d.scale[k0 + kk];
    tile[kk * 65 + n4] = v[0]; tile[kk * 65 + n4 + 1] = v[1]; tile[kk * 65 + n4 + 2] = v[2]; tile[kk * 65 + n4 + 3] = v[3];
  }
  __syncthreads();
  {
    const int nn = tid >> 3, kc = (tid & 7) * 8;
    if (n0 + nn < d.N) {
      u32x4 o;
#pragma unroll
      for (int j = 0; j < 4; ++j) o[j] = cvt_pk_bf16(tile[(kc + 2 * j) * 65 + nn], tile[(kc + 2 * j + 1) * 65 + nn]);
      *(u32x4*)(d.dst + (size_t)(n0 + nn) * d.ldd + k0 + kc) = o;
    }
  }
  __syncthreads();
}
DI void convert_weights(const Params& p, int l, char* smem, int t_first, int t_stride, int t_begin, int t_end) {
  char* ws = p.ws + wset(l);
  const float* win = p.w_in + (size_t)l * DM * INC;
  const int cnt[12] = {16 * 32, 16 * 12, 16 * 4, 16 * 24, 16 * 1, 12 * 12, 4 * 16, 8 * 16, 8 * 16, 16 * 16, 16 * 64, 64 * 16};
  int total = 0;
#pragma unroll
  for (int i = 0; i < 12; ++i) total += cnt[i];
  if (t_end > total) t_end = total;
  for (int t = t_begin + t_first; t < t_end; t += t_stride) {
    int which = 0, rem = t;
#pragma unroll
    for (int i = 0; i < 12; ++i) { if (which == i && rem >= cnt[i]) { rem -= cnt[i]; which = i + 1; } }
    ConvDesc d;
    switch (which) {
      case 0: d = {win, INC, 0, 1024, 2048, (bf16_t*)(ws + O_WG), 1024, nullptr}; break;
      case 1: d = {win, INC, 2048, 1024, 768, (bf16_t*)(ws + O_WP), 1024, nullptr}; break;
      case 2: d = {win, INC, 2816, 1024, 256, (bf16_t*)(ws + O_WP) + (size_t)768 * 1024, 1024, nullptr}; break;
      case 3: d = {win, INC, 3104, 1024, 1536, (bf16_t*)(ws + O_WP) + (size_t)1024 * 1024, 1024, nullptr}; break;
      case 4: d = {win, INC, 3072, 1024, 32, (bf16_t*)(ws + O_WP) + (size_t)2560 * 1024, 1024, nullptr}; break;
      case 5: d = {p.w_uq + (size_t)l * 768 * 768, 768, 0, 768, 768, (bf16_t*)(ws + O_WUQ), 768, p.g_qa + l * 768}; break;
      case 6: d = {p.w_ukv + (size_t)l * 256 * 1024, 1024, 0, 256, 1024, (bf16_t*)(ws + O_WUKV), 256, p.g_kva + l * 256}; break;
      case 7: d = {p.w_mla_o + (size_t)l * 512 * 1024, 1024, 0, 512, 1024, (bf16_t*)(ws + O_WMO), 512, nullptr}; break;
      case 8: d = {p.w_na_o + (size_t)l * 512 * 1024, 1024, 0, 512, 1024, (bf16_t*)(ws + O_WNO), 512, nullptr}; break;
      case 9: d = {p.w_out + (size_t)l * 1024 * 1024, 1024, 0, 1024, 1024, (bf16_t*)(ws + O_WOUT), 1024, nullptr}; break;
      case 10: d = {p.w_ff1 + (size_t)l * 1024 * 4096, 4096, 0, 1024, 4096, (bf16_t*)(ws + O_WFF1), 1024, nullptr}; break;
      default: d = {p.w_ff2 + (size_t)l * 4096 * 1024, 1024, 0, 4096, 1024, (bf16_t*)(ws + O_WFF2), 4096, nullptr}; break;
    }
    conv_tile(d, rem, smem);
  }
}
DI void zero_wp_pad(const Params& p, int l) {
  u32x4* z = (u32x4*)((bf16_t*)(p.ws + wset(l) + O_WP) + (size_t)2592 * 1024);
  const int n16 = 224 * 1024 * 2 / 16;
  for (int i = blockIdx.x * 512 + (int)threadIdx.x; i < n16; i += gridDim.x * 512) z[i] = (u32x4){0u, 0u, 0u, 0u};
}

DI void phase0(const Params& p, char* smem) {
  char* ws = p.ws;
  const int tid = otid();
  if (blockIdx.x == gridDim.x - 1) {
    float* tab = (float*)(ws + O_TAB);
    for (int i = tid; i < 512; i += 512) {
      const int pos = i >> 3, f = i & 7;
      const float inv = powf(10000.f, -(float)f / 8.f);
      const float ang = (float)pos * inv;
      tab[i * 2] = cosf(ang); tab[i * 2 + 1] = sinf(ang);
    }
  }
  float* sc = (float*)smem;
  float* red = (float*)(smem + 36864);
  float* mod = (float*)(ws + O_MOD);
  for (int it = blockIdx.x; it < NLAYER * 96; it += gridDim.x) {
    const int l = it / 96, cgp = it % 96;
    for (int idx = tid; idx < 9 * 1024; idx += 512) {
      const int r = idx >> 10, k = idx & 1023;
      const float v = (r < 8) ? p.c[r * 1024 + k] : p.c_ctx[k];
      sc[idx] = v / (1.f + expf(-v));
    }
    __syncthreads();
    const int w = tid >> 6, lane = tid & 63, col = cgp * 64 + lane;
    float a[9];
#pragma unroll
    for (int r = 0; r < 9; ++r) a[r] = 0.f;
    const float* wp = p.w_ada + (size_t)l * 1024 * 6144 + col;
#pragma unroll 4
    for (int k = w * 128; k < w * 128 + 128; ++k) {
      const float wv = wp[(size_t)k * 6144];
#pragma unroll
      for (int r = 0; r < 9; ++r) a[r] += sc[r * 1024 + k] * wv;
    }
#pragma unroll
    for (int r = 0; r < 9; ++r) red[(w * 9 + r) * 64 + lane] = a[r];
    __syncthreads();
    for (int idx = tid; idx < 9 * 64; idx += 512) {
      const int r = idx >> 6, ln = idx & 63;
      float s = 0.f;
#pragma unroll
      for (int ww = 0; ww < 8; ++ww) s += red[(ww * 9 + r) * 64 + ln];
      mod[(size_t)(l * 9 + r) * 6144 + cgp * 64 + ln] = s + p.b_ada[l * 6144 + cgp * 64 + ln];
    }
    __syncthreads();
  }
}

DI void phase_norm(const Params& p, int l, const float* g, int shift_idx, bool skip_ctx, bool from_input) {
  const int tid = otid(), lane = tid & 63, w = tid >> 6;
  const float* mod = (const float*)(p.ws + O_MOD) + (size_t)l * 9 * 6144;
  bf16_t* hb = (bf16_t*)(p.ws + O_HB);
  const int stride = gridDim.x * 8;
  for (int row0 = blockIdx.x * 8 + w; row0 < TT; row0 += 2 * stride) {
    f32x4 v[2][4];
    bool act[2];
    int rows[2];
#pragma unroll
    for (int u = 0; u < 2; ++u) {
      const int row = row0 + u * stride;
      rows[u] = row;
      const int b = row / TPB, t = row - b * TPB;
      act[u] = (row < TT) && !(skip_ctx && t < CTXL);
      if (act[u]) {
        const float* xr = xrow_src(p, row, from_input);
#pragma unroll
        for (int i = 0; i < 4; ++i) v[u][i] = *(const f32x4*)(xr + lane * 4 + i * 256);
      } else {
#pragma unroll
        for (int i = 0; i < 4; ++i) v[u][i] = (f32x4){0.f, 0.f, 0.f, 0.f};
      }
    }
#pragma unroll
    for (int u = 0; u < 2; ++u) {
      if (!act[u]) continue;
      const int row = rows[u];
      const int b = row / TPB, t = row - b * TPB;
      float ss = 0.f;
#pragma unroll
      for (int i = 0; i < 4; ++i) ss += v[u][i][0] * v[u][i][0] + v[u][i][1] * v[u][i][1] + v[u][i][2] * v[u][i][2] + v[u][i][3] * v[u][i][3];
      ss = wave_sum(ss);
      const float rs = rsqrtf(ss * (1.f / 1024.f) + EPS);
      const float* mr = mod + (size_t)(t < CTXL ? 8 : b) * 6144 + shift_idx * 1024;
#pragma unroll
      for (int i = 0; i < 4; ++i) {
        const int col = lane * 4 + i * 256;
        const f32x4 gg = *(const f32x4*)(g + col), sh = *(const f32x4*)(mr + col), scl = *(const f32x4*)(mr + 1024 + col);
        f32x4 y = (v[u][i] * rs) * gg;
        y = y * (scl + 1.f) + sh;
        u32x2 pk; pk.x = cvt_pk_bf16(y[0], y[1]); pk.y = cvt_pk_bf16(y[2], y[3]);
        *(u32x2*)(hb + (size_t)row * 1024 + col) = pk;
      }
    }
  }
}

DI void rowstats_item(const Params& p, int item) {
  const int tid = otid(), lane = tid & 63, w = tid >> 6;
  const bf16_t* pb = (const bf16_t*)(p.ws + O_PB);
  float* st = (float*)(p.ws + O_STAT);
#pragma unroll 1
  for (int i = 0; i < 2; ++i) {
    const int row = item * 16 + w * 2 + i;
    const bf16_t* pr = pb + (size_t)row * PBW;
    float sq = 0.f, sk = 0.f;
    {
      u32x4 u = *(const u32x4*)(pr + lane * 8);
#pragma unroll
      for (int j = 0; j < 4; ++j) { float a = bflo(u[j]), b2 = bfhi(u[j]); sq += a * a + b2 * b2; }
    }
    if (lane < 32) {
      u32x4 u = *(const u32x4*)(pr + 512 + lane * 8);
#pragma unroll
      for (int j = 0; j < 4; ++j) { float a = bflo(u[j]), b2 = bfhi(u[j]); sq += a * a + b2 * b2; }
      u32x4 u2 = *(const u32x4*)(pr + 768 + lane * 8);
#pragma unroll
      for (int j = 0; j < 4; ++j) { float a = bflo(u2[j]), b2 = bfhi(u2[j]); sk += a * a + b2 * b2; }
    }
    sq = wave_sum(sq); sk = wave_sum(sk);
    if (lane == 0) { st[row * 2] = rsqrtf(sq * (1.f / 768.f) + EPS); st[row * 2 + 1] = rsqrtf(sk * (1.f / 256.f) + EPS); }
  }
}

DI void rope8(float (&x1)[8], float (&x2)[8], const float* tabrow) {
#pragma unroll
  for (int i = 0; i < 8; ++i) {
    const float c = tabrow[i * 2], s = tabrow[i * 2 + 1];
    const float a = x1[i], b = x2[i];
    x1[i] = a * c - b * s; x2[i] = a * s + b * c;
  }
}
DI void unpack8(const u32x4& u, float (&f)[8]) {
#pragma unroll
  for (int j = 0; j < 4; ++j) { f[2 * j] = bflo(u[j]); f[2 * j + 1] = bfhi(u[j]); }
}
DI u32x4 pack8(const float (&f)[8]) {
  u32x4 u;
#pragma unroll
  for (int j = 0; j < 4; ++j) u[j] = cvt_pk_bf16(f[2 * j], f[2 * j + 1]);
  return u;
}
DI float sumsq8(const u32x4& u) {
  float s = 0.f;
#pragma unroll
  for (int j = 0; j < 4; ++j) { float a = bflo(u[j]), b = bfhi(u[j]); s += a * a + b * b; }
  return s;
}
template <int NCH, bool ROPE>
DI void norm_rows16(int lane, size_t row0, bool is_ctx, int t0, const bf16_t* srcA, size_t ldA, int nA, const bf16_t* srcB, size_t ldB,
                    const float* st, int st_idx, const float* gain, float inv_n, bf16_t* dst, size_t ldd, const float* tab) {
  const int sub = lane & 15, tq = lane >> 4;
  const bool actv = sub < NCH, fromA = sub < nA;
  float gv[8];
#pragma unroll
  for (int j = 0; j < 8; ++j) gv[j] = actv ? gain[sub * 8 + j] : 0.f;
  u32x4 ua[16];
  float prea[16];
#pragma unroll
  for (int it = 0; it < 16; ++it) {
    const size_t row = row0 + it * 4 + tq;
    ua[it] = (u32x4){0u, 0u, 0u, 0u};
    if (actv) ua[it] = *(const u32x4*)(fromA ? srcA + row * ldA + sub * 8 : srcB + row * ldB + (sub - nA) * 8);
    prea[it] = 1.f;
    if (st_idx >= 0 && fromA) prea[it] = st[row * 2 + st_idx];
  }
#pragma unroll
  for (int it = 0; it < 16; ++it) {
    const int tk = it * 4 + tq;
    const size_t row = row0 + tk;
    const u32x4 u = ua[it];
    const float pre = prea[it];
    float f[8];
    unpack8(u, f);
    float ss = 0.f;
#pragma unroll
    for (int j = 0; j < 8; ++j) { f[j] *= pre; ss += f[j] * f[j]; }
    ss += __shfl_xor(ss, 1); ss += __shfl_xor(ss, 2); ss += __shfl_xor(ss, 4); ss += __shfl_xor(ss, 8);
    const float rs = rsqrtf(ss * inv_n + EPS);
#pragma unroll
    for (int j = 0; j < 8; ++j) f[j] *= rs * gv[j];
    if (ROPE) {
      float pf[8];
#pragma unroll
      for (int j = 0; j < 8; ++j) pf[j] = __shfl_xor(f[j], 1);
      if (!is_ctx && sub >= 8 && sub < 12) {
        const int pos = t0 + tk - CTXL;
        const float* tr = (const float*)smem + ((sub < 10) ? (pos >> 6) : (pos & 63)) * 16;
#pragma unroll
        for (int j = 0; j < 8; ++j) {
          const float c = tr[2 * j], sn = tr[2 * j + 1];
          f[j] = (sub & 1) ? (pf[j] * sn + f[j] * c) : (f[j] * c - pf[j] * sn);
        }
      }
    }
    if (actv) *(u32x4*)(dst + row * ldd + sub * 8) = pack8(f);
  }
}
DI void copy_rows8(int lane, size_t row0, const bf16_t* src, size_t lds_, const float* st, bf16_t* dst, size_t ldd) {
  const int sub = lane & 7, tq = lane >> 3;
  u32x4 ua[8];
  float sc[8];
#pragma unroll
  for (int it = 0; it < 8; ++it) {
    const size_t row = row0 + it * 8 + tq;
    ua[it] = *(const u32x4*)(src + row * lds_ + sub * 8);
    sc[it] = st ? st[row * 2 + 1] : 1.f;
  }
#pragma unroll
  for (int it = 0; it < 8; ++it) {
    const size_t row = row0 + it * 8 + tq;
    float f[8];
    unpack8(ua[it], f);
#pragma unroll
    for (int j = 0; j < 8; ++j) f[j] *= sc[it];
    *(u32x4*)(dst + row * ldd + sub * 8) = pack8(f);
  }
}
DI void finalize_wave_item(const Params& p, int l, int wi) {
  char* ws = p.ws;
  const int lane = otid() & 63;
  const int part = wi % 3, rest = wi / 3, h = rest & 7, g = rest >> 3;
  const int row = g * 64 + lane;
  const size_t row0 = (size_t)g * 64;
  const int b = g / 36, t0 = (g % 36) * 64, t = t0 + lane;
  const bool is_ctx = t0 < CTXL;
  const float* tab = (const float*)(ws + O_TAB);
  const bf16_t* pb0 = (const bf16_t*)(ws + O_PB);
  const bf16_t* qk0 = (const bf16_t*)(ws + O_QK2);
  const bf16_t* pb = pb0 + (size_t)row * PBW;
  const bf16_t* qk = qk0 + (size_t)row * QKW;
  const float* st0 = (const float*)(ws + O_STAT);
  const float* st = st0 + row * 2;
  if (part == 0) {
    norm_rows16<12, true>(lane, row0, is_ctx, t0, qk0 + h * 96, QKW, 12, qk0, QKW, st0, 0, p.g_mla_q + l * 96, 1.f / 96.f,
                          (bf16_t*)(ws + O_MQ) + h * 96, 768, tab);
  } else if (part == 1) {
    norm_rows16<12, true>(lane, row0, is_ctx, t0, qk0 + 768 + h * 128, QKW, 8, pb0 + 2560, PBW, st0, 1, p.g_mla_k + l * 96, 1.f / 96.f,
                          (bf16_t*)(ws + O_MK) + h * 96, 768, tab);
    copy_rows8(lane, row0, qk0 + 768 + h * 128 + 64, QKW, st0, (bf16_t*)(ws + O_MVT) + h * 64, 512);
  } else {
    norm_rows16<8, false>(lane, row0, is_ctx, t0, pb0 + 1024 + h * 64, PBW, 8, pb0, PBW, st0, -1, p.g_na_q + l * 64, 1.f / 64.f,
                          (bf16_t*)(ws + O_NQ) + h * 64, 512, tab);
    norm_rows16<8, false>(lane, row0, is_ctx, t0, pb0 + 1536 + h * 64, PBW, 8, pb0, PBW, st0, -1, p.g_na_k + l * 64, 1.f / 64.f,
                          (bf16_t*)(ws + O_NK) + h * 64, 512, tab);
  }
}

template <int DQK, bool NA, bool SMAX, int LDV>
DI void attn_item(const bf16_t* __restrict__ Qp, int ldq, const bf16_t* __restrict__ Kp, int ldk, const bf16_t* __restrict__ Vp  ,
                  int nkt, int koff, float c1, float m0, int r0, int rs, const float* __restrict__ rpb_g, bf16_t* __restrict__ Op, char* smem) {
  constexpr int KSTR = DQK * 2 + 32, KBYTES = 64 * KSTR, VSTR = 160, VBYTES = 64 * VSTR, STG = KBYTES + VBYTES;
  constexpr int CPK = DQK / 8, NKC = (64 * CPK + 511) / 512, NDS = DQK / 32;
  const int tid = otid(), lane = tid & 63, w = tid >> 6, fr = lane & 15, fq = lane >> 4;
  float* rpbl = (float*)(smem + 2 * STG);
  if (NA) { for (int i = tid; i < 465; i += 512) rpbl[i] = rpb_g[i] * LOG2E; }
  bf16x8 qf[2][NDS];
#pragma unroll
  for (int qt = 0; qt < 2; ++qt)
#pragma unroll
    for (int ds = 0; ds < NDS; ++ds) qf[qt][ds] = *(const bf16x8*)(Qp + (size_t)(w * 32 + qt * 16 + fr) * ldq + ds * 32 + fq * 8);
  u32x4 rkA[NKC], rvA, rkB[NKC], rvB;
  int kkey[NKC], kcc[NKC];
  bool kval[NKC];
#pragma unroll
  for (int i = 0; i < NKC; ++i) { const int c = tid + i * 512; kval[i] = c < 64 * CPK; kkey[i] = kval[i] ? c / CPK : 0; kcc[i] = kval[i] ? c - kkey[i] * CPK : 0; }
  const int vdv = tid >> 3, vcc = tid & 7;
  {
#pragma unroll
    for (int i = 0; i < NKC; ++i) rkA[i] = *(const u32x4*)(Kp + (size_t)kkey[i] * ldk + kcc[i] * 8);
    rvA = *(const u32x4*)(Vp + (size_t)vdv * LDV + vcc * 8);
    if (nkt > 1) {
      const int kb = 64;
#pragma unroll
      for (int i = 0; i < NKC; ++i) rkB[i] = *(const u32x4*)(Kp + (size_t)(kb + kkey[i]) * ldk + kcc[i] * 8);
      rvB = *(const u32x4*)(Vp + (size_t)(kb + vdv) * LDV + vcc * 8);
    }
#pragma unroll
    for (int i = 0; i < NKC; ++i) if (kval[i]) *(u32x4*)(smem + kkey[i] * KSTR + kcc[i] * 16) = rkA[i];
    *(u32x4*)(smem + KBYTES + vdv * VSTR + vcc * 16) = rvA;
  }
  __syncthreads();
  f32x4 o[4][2];
  float mrun[2], lrun[2];
#pragma unroll
  for (int qt = 0; qt < 2; ++qt) {
    mrun[qt] = -1e30f; lrun[qt] = 0.f;
#pragma unroll
    for (int d = 0; d < 4; ++d) o[d][qt] = (f32x4){0.f, 0.f, 0.f, 0.f};
  }
  auto step = [&](const int it, u32x4 (&rk_ld)[NKC], u32x4& rv_ld, u32x4 (&rk_wr)[NKC], u32x4& rv_wr) __attribute__((always_inline)) {
    const int cur = it & 1;
    const bool more = it + 1 < nkt;
    if (it + 2 < nkt) {
      const int kb = (it + 2) * 64 + ((it + 2) >= 4 ? koff : 0);
#pragma unroll
      for (int i = 0; i < NKC; ++i) rk_ld[i] = *(const u32x4*)(Kp + (size_t)(kb + kkey[i]) * ldk + kcc[i] * 8);
      rv_ld = *(const u32x4*)(Vp + (size_t)(kb + vdv) * LDV + vcc * 8);
    }
    __builtin_amdgcn_sched_barrier(0);
    const char* ks = smem + cur * STG;
    const char* vs = ks + KBYTES;
    f32x4 s[4][2];
#pragma unroll
    for (int kt = 0; kt < 4; ++kt) { s[kt][0] = (f32x4){0.f, 0.f, 0.f, 0.f}; s[kt][1] = (f32x4){0.f, 0.f, 0.f, 0.f}; }
#pragma unroll
    for (int ds = 0; ds < NDS; ++ds) {
      bf16x8 kf[4];
#pragma unroll
      for (int kt = 0; kt < 4; ++kt) kf[kt] = *(const bf16x8*)(ks + (kt * 16 + fr) * KSTR + ds * 64 + fq * 16);
#pragma unroll
      for (int kt = 0; kt < 4; ++kt) {
        s[kt][0] = __builtin_amdgcn_mfma_f32_16x16x32_bf16(kf[kt], qf[0][ds], s[kt][0], 0, 0, 0);
        s[kt][1] = __builtin_amdgcn_mfma_f32_16x16x32_bf16(kf[kt], qf[1][ds], s[kt][1], 0, 0, 0);
      }
    }
    bf16x8 vfr[2][4];
#pragma unroll
    for (int k2 = 0; k2 < 2; ++k2)
#pragma unroll
      for (int d = 0; d < 4; ++d) {
        const char* vp = vs + (k2 * 32 + fq * 4 + (fr >> 2)) * VSTR + d * 32 + (fr & 3) * 8;
        typedef short s16x4_t __attribute__((ext_vector_type(4)));
        const s16x4_t lo = __builtin_amdgcn_ds_read_tr16_b64_v4i16((__attribute__((address_space(3))) s16x4_t*)(vp));
        const s16x4_t hi = __builtin_amdgcn_ds_read_tr16_b64_v4i16((__attribute__((address_space(3))) s16x4_t*)(vp + 16 * VSTR));
        vfr[k2][d] = __builtin_shufflevector(lo, hi, 0, 1, 2, 3, 4, 5, 6, 7);
      }
    __builtin_amdgcn_sched_barrier(0);
    if (SMAX) {
#pragma unroll
      for (int qt = 0; qt < 2; ++qt) {
        float sum = 0.f;
        if (NA && it >= 4) {
          const int kr = rs + (it - 4);
          const int ql = w * 32 + qt * 16 + fr, qr = r0 + (ql >> 6), qc = ql & 63;
          const int rst = min(max(qr - 4, 0), 24);
          const bool rowok = (kr >= rst) && (kr < rst + 8);
          const int cst = min(max(qc - 8, 0), 48);
          const int base = (kr - qr + 7) * 31 + 15 - qc;
          float bv[4][4];
#pragma unroll
          for (int kt = 0; kt < 4; ++kt)
#pragma unroll
            for (int j = 0; j < 4; ++j) bv[kt][j] = rpbl[min(max(base + kt * 16 + fq * 4 + j, 0), 464)];
#pragma unroll
          for (int kt = 0; kt < 4; ++kt)
#pragma unroll
            for (int j = 0; j < 4; ++j) {
              const int kc = kt * 16 + fq * 4 + j;
              const float okf = (rowok && (kc >= cst) && (kc < cst + 16)) ? 1.f : 0.f;
              const float pv = __builtin_amdgcn_exp2f(__builtin_fmaf(s[kt][qt][j], c1, bv[kt][j] - m0)) * okf;
              s[kt][qt][j] = pv; sum += pv;
            }
        } else {
#pragma unroll
          for (int kt = 0; kt < 4; ++kt)
#pragma unroll
            for (int j = 0; j < 4; ++j) { const float pv = __builtin_amdgcn_exp2f(__builtin_fmaf(s[kt][qt][j], c1, -m0)); s[kt][qt][j] = pv; sum += pv; }
        }
        lrun[qt] += sum;
      }
    } else {
#pragma unroll
    for (int qt = 0; qt < 2; ++qt) {
      float mx = -1e30f;
      if (NA && it >= 4) {
        const int kr = rs + (it - 4);
        const int ql = w * 32 + qt * 16 + fr, qr = r0 + (ql >> 6), qc = ql & 63;
        const int rst = min(max(qr - 4, 0), 24);
        const bool rowok = (kr >= rst) && (kr < rst + 8);
        const int cst = min(max(qc - 8, 0), 48);
        const int base = (kr - qr + 7) * 31 + 15 - qc;
        float bv[4][4];
#pragma unroll
        for (int kt = 0; kt < 4; ++kt)
#pragma unroll
          for (int j = 0; j < 4; ++j) bv[kt][j] = rpbl[min(max(base + kt * 16 + fq * 4 + j, 0), 464)];
#pragma unroll
        for (int kt = 0; kt < 4; ++kt)
#pragma unroll
          for (int j = 0; j < 4; ++j) {
            const int kc = kt * 16 + fq * 4 + j;
            const float okf = (rowok && (kc >= cst) && (kc < cst + 16)) ? 1.f : 0.f;
            const float tv = __builtin_fmaf(s[kt][qt][j], c1, bv[kt][j]) * okf - (1.f - okf) * 1e30f;
            s[kt][qt][j] = tv; mx = fmaxf(mx, tv);
          }
      } else {
#pragma unroll
        for (int kt = 0; kt < 4; ++kt)
#pragma unroll
          for (int j = 0; j < 4; ++j) { const float tv = s[kt][qt][j] * c1; s[kt][qt][j] = tv; mx = fmaxf(mx, tv); }
      }
      mx = fmaxf(mx, __shfl_xor(mx, 16));
      mx = fmaxf(mx, __shfl_xor(mx, 32));
      const float mnew = fmaxf(mrun[qt], mx);
      const float alpha = __builtin_amdgcn_exp2f(mrun[qt] - mnew);
      mrun[qt] = mnew;
      float sum = 0.f;
#pragma unroll
      for (int kt = 0; kt < 4; ++kt)
#pragma unroll
        for (int j = 0; j < 4; ++j) { const float pv = __builtin_amdgcn_exp2f(s[kt][qt][j] - mnew); s[kt][qt][j] = pv; sum += pv; }
      lrun[qt] = lrun[qt] * alpha + sum;
#pragma unroll
      for (int d = 0; d < 4; ++d) o[d][qt] = o[d][qt] * alpha;
    }
    }
#pragma unroll
    for (int k2 = 0; k2 < 2; ++k2) {
      bf16x8 pf[2];
#pragma unroll
      for (int qt = 0; qt < 2; ++qt) {
        u32x4 u;
        u[0] = cvt_pk_bf16(s[2 * k2][qt][0], s[2 * k2][qt][1]); u[1] = cvt_pk_bf16(s[2 * k2][qt][2], s[2 * k2][qt][3]);
        u[2] = cvt_pk_bf16(s[2 * k2 + 1][qt][0], s[2 * k2 + 1][qt][1]); u[3] = cvt_pk_bf16(s[2 * k2 + 1][qt][2], s[2 * k2 + 1][qt][3]);
        pf[qt] = __builtin_bit_cast(bf16x8, u);
      }
#pragma unroll
      for (int d = 0; d < 4; ++d) {
        o[d][0] = __builtin_amdgcn_mfma_f32_16x16x32_bf16(vfr[k2][d], pf[0], o[d][0], 0, 0, 0);
        o[d][1] = __builtin_amdgcn_mfma_f32_16x16x32_bf16(vfr[k2][d], pf[1], o[d][1], 0, 0, 0);
      }
    }
    if (more) {
      char* nx = smem + (cur ^ 1) * STG;
#pragma unroll
      for (int i = 0; i < NKC; ++i) if (kval[i]) *(u32x4*)(nx + kkey[i] * KSTR + kcc[i] * 16) = rk_wr[i];
      *(u32x4*)(nx + KBYTES + vdv * VSTR + vcc * 16) = rv_wr;
    }
    __syncthreads();
  };
  for (int it = 0; it < nkt; it += 2) {
    step(it, rkA, rvA, rkB, rvB);
    if (it + 1 < nkt) step(it + 1, rkB, rvB, rkA, rvA);
  }
#pragma unroll
  for (int qt = 0; qt < 2; ++qt) {
    float lt = lrun[qt];
    lt += __shfl_xor(lt, 16);
    lt += __shfl_xor(lt, 32);
    const float inv = 1.f / lt;
#pragma unroll
    for (int d = 0; d < 4; ++d) {
      u32x2 pk; pk.x = cvt_pk_bf16(o[d][qt][0] * inv, o[d][qt][1] * inv); pk.y = cvt_pk_bf16(o[d][qt][2] * inv, o[d][qt][3] * inv);
      *(u32x2*)(Op + (size_t)(w * 32 + qt * 16 + fr) * 512 + d * 16 + fq * 4) = pk;
    }
  }
}

DI void phase_attn(const Params& p, int l, bool last, char* smem) {
  char* ws = p.ws;
  const bf16_t* mq = (const bf16_t*)(ws + O_MQ); const bf16_t* mk = (const bf16_t*)(ws + O_MK); const bf16_t* mvt = (const bf16_t*)(ws + O_MVT);
  const bf16_t* nq = (const bf16_t*)(ws + O_NQ); const bf16_t* nk = (const bf16_t*)(ws + O_NK);
  const bf16_t* pbv = (const bf16_t*)(ws + O_PB) + 2048;
  bf16_t* ymla = (bf16_t*)(ws + O_YMLA); bf16_t* yna = (bf16_t*)(ws + O_YNA);
  const float c_mla = LOG2E * 0.10206207261596575f;
  const float c_na = LOG2E * 0.125f;
  float m0_mla, m0_na;
  {
    const int tid = otid();
    float a = 0.f, b2 = 0.f, c = 0.f, d = 0.f, e = 0.f;
    if (tid < 96) { a = fabsf(p.g_mla_q[l * 96 + tid]); b2 = fabsf(p.g_mla_k[l * 96 + tid]); }
    if (tid < 64) { c = fabsf(p.g_na_q[l * 64 + tid]); d = fabsf(p.g_na_k[l * 64 + tid]); }
    for (int i = tid; i < 8 * 465; i += 512) e = fmaxf(e, p.rpb[(size_t)l * 8 * 465 + i]);
#pragma unroll
    for (int o = 32; o >= 1; o >>= 1) { a = fmaxf(a, __shfl_xor(a, o)); b2 = fmaxf(b2, __shfl_xor(b2, o)); c = fmaxf(c, __shfl_xor(c, o)); d = fmaxf(d, __shfl_xor(d, o)); e = fmaxf(e, __shfl_xor(e, o)); }
    float* red = (float*)smem;
    if ((tid & 63) == 0) { const int w = tid >> 6; red[w * 8 + 0] = a; red[w * 8 + 1] = b2; red[w * 8 + 2] = c; red[w * 8 + 3] = d; red[w * 8 + 4] = e; }
    __syncthreads();
    a = b2 = c = d = e = 0.f;
#pragma unroll
    for (int w = 0; w < 8; ++w) { a = fmaxf(a, red[w * 8]); b2 = fmaxf(b2, red[w * 8 + 1]); c = fmaxf(c, red[w * 8 + 2]); d = fmaxf(d, red[w * 8 + 3]); e = fmaxf(e, red[w * 8 + 4]); }
    __syncthreads();
    m0_mla = c_mla * 96.f * a * b2;
    m0_na = c_na * 64.f * c * d + e * LOG2E;
  }
  const bool smax_mla = m0_mla < 64.f, smax_na = m0_na < 64.f;
  for (int item = blockIdx.x; item < 1024; item += gridDim.x) {
    const int kind = item >> 9, it2 = item & 511;
    const int xx = it2 & 7, yy = it2 >> 3;
    const int bh = xx + 8 * (yy >> 3), qt = yy & 7;
    const int b = bh >> 3, h = bh & 7;
    const int q0 = b * TPB + CTXL + qt * 256;
    if (kind == 0) {
      if (smax_mla) attn_item<96, false, true, 512>(mq + (size_t)q0 * 768 + h * 96, 768, mk + (size_t)b * TPB * 768 + h * 96, 768, mvt + (size_t)b * TPB * 512 + h * 64,
                           36, 0, c_mla, m0_mla, 0, 0, nullptr, ymla + (size_t)q0 * 512 + h * 64, smem);
      else attn_item<96, false, false, 512>(mq + (size_t)q0 * 768 + h * 96, 768, mk + (size_t)b * TPB * 768 + h * 96, 768, mvt + (size_t)b * TPB * 512 + h * 64,
                           36, 0, c_mla, 0.f, 0, 0, nullptr, ymla + (size_t)q0 * 512 + h * 64, smem);
    } else {
      const int r0 = qt * 4;
      const int rs = min(max(r0 - 4, 0), 24);
      const int re = min(max(r0 + 3 - 4, 0), 24) + 8;
      if (smax_na) attn_item<64, true, true, PBW>(nq + (size_t)q0 * 512 + h * 64, 512, nk + (size_t)b * TPB * 512 + h * 64, 512, pbv + (size_t)b * TPB * PBW + h * 64,
                          4 + (re - rs), rs * 64, c_na, m0_na, r0, rs, p.rpb + ((size_t)l * 8 + h) * 465, yna + (size_t)q0 * 512 + h * 64, smem);
      else attn_item<64, true, false, PBW>(nq + (size_t)q0 * 512 + h * 64, 512, nk + (size_t)b * TPB * 512 + h * 64, 512, pbv + (size_t)b * TPB * PBW + h * 64,
                          4 + (re - rs), rs * 64, c_na, 0.f, r0, rs, p.rpb + ((size_t)l * 8 + h) * 465, yna + (size_t)q0 * 512 + h * 64, smem);
    }
  }
  {
    const bf16_t* hbp = (const bf16_t*)(ws + O_HB);
    const bf16_t* wg = (const bf16_t*)(ws + wset(l) + O_WG);
    bf16_t* gp = (bf16_t*)(ws + O_GATE);
    const int b0 = blockIdx.x, Gd = gridDim.x;
    gemm_stream<1024, 1024, 1024>(
        [&](int i, const bf16_t*& A, const bf16_t*& B) {
          int rt, ct;
          if (!tile_of(b0 + i * Gd, true, 8, rt, ct)) return false;
          A = hbp + (size_t)rt * 256 * 1024; B = wg + (size_t)ct * 256 * 1024; return true;
        },
        [&](int i, acc_t& acc) {
          int rt, ct;
          tile_of(b0 + i * Gd, true, 8, rt, ct);
          store_bf16_tile<2>(acc, gp + (size_t)rt * 256 * PBW + ct * 256, PBW);
        });
  }
  if (!last) {
    for (int it2 = blockIdx.x; it2 < 128; it2 += gridDim.x) {
      const int kind = it2 >> 6, bh = it2 & 63;
      const int b = bh >> 3, h = bh & 7;
      const int q0 = b * TPB;
      if (kind == 0)
        attn_item<96, false, false, 512>(mq + (size_t)q0 * 768 + h * 96, 768, mk + (size_t)b * TPB * 768 + h * 96, 768, mvt + (size_t)b * TPB * 512 + h * 64,
                             4, 0, c_mla, 0.f, 0, 0, nullptr, ymla + (size_t)q0 * 512 + h * 64, smem);
      else
        attn_item<64, false, false, PBW>(nq + (size_t)q0 * 512 + h * 64, 512, nk + (size_t)b * TPB * 512 + h * 64, 512, pbv + (size_t)b * TPB * PBW + h * 64,
                             4, 0, c_na, 0.f, 0, 0, nullptr, yna + (size_t)q0 * 512 + h * 64, smem);
    }
  }
}

#define XB_TMO      128
#define XB_XCNT(j)  (256  + 64 * (j))
#define XB_XSUB(j)  (1280 + 64 * (j))
#define XB_XGEN(j)  (2304 + 64 * (j))
#define XB_TOP      3328
#define XB_TOPGEN   3392
#define XCD_BAR_WORDS 3456
#define XB_SPIN_CAP (1u << 18)
#define LAS __attribute__((address_space(3)))

__device__ __forceinline__ unsigned xb_ld(unsigned* p)              { return __hip_atomic_load(p, __ATOMIC_RELAXED, __HIP_MEMORY_SCOPE_AGENT); }
__device__ __forceinline__ unsigned xb_add(unsigned* p, unsigned v) { return __hip_atomic_fetch_add(p, v, __ATOMIC_RELAXED, __HIP_MEMORY_SCOPE_AGENT); }
__device__ __forceinline__ unsigned xb_xcc_id() { return (unsigned)__builtin_amdgcn_s_getreg((3 << 11) | 20) & 0xFu; }
#define XB_SPIN(cond, bar) do { unsigned _sp = 0; while (cond) { __builtin_amdgcn_s_sleep(1); \
    if ((++_sp & 255u) == 0u) { if (xb_ld(&(bar)[XB_TMO])) break; if (_sp > XB_SPIN_CAP) { atomicAdd(&(bar)[XB_TMO], 1u); break; } } } } while (0)

struct XcdBarrier {
    unsigned* bar; unsigned x;
    volatile LAS unsigned* st;
};

__device__ __forceinline__ XcdBarrier xcd_barrier_post(unsigned* bar, volatile LAS unsigned* st) {
    XcdBarrier b; b.bar = bar; b.x = xb_xcc_id(); b.st = st;
    if (threadIdx.x == 0) (void)xb_add(&bar[XB_XCNT(b.x)], 1u);
    return b;
}
__device__ __forceinline__ void xcd_barrier_complete(unsigned* bar, unsigned x, unsigned& nloc, unsigned& nx) {
    const unsigned G = gridDim.x * gridDim.y * gridDim.z;
    unsigned sum, cnt, mine, sp = 0u;
    for (;;) {
        sum = 0u; cnt = 0u; mine = 0u;
#pragma unroll
        for (unsigned j = 0; j < 16; ++j) { const unsigned c = xb_ld(&bar[XB_XCNT(j)]); sum += c; cnt += (c > 0u) ? 1u : 0u; mine = (j == x) ? c : mine; }
        if (sum == G) break;
        __builtin_amdgcn_s_sleep(1);
        if ((++sp & 255u) == 0u) { if (xb_ld(&bar[XB_TMO])) break; if (sp > XB_SPIN_CAP) { atomicAdd(&bar[XB_TMO], 1u); break; } }
    }
    nloc = mine > 0u ? mine : 1u; nx = cnt > 0u ? cnt : 1u;
}

__device__ __forceinline__ void xcd_barrier(const XcdBarrier& b) {
    asm volatile("s_waitcnt vmcnt(0)" ::: "memory");
    __syncthreads();
    if (threadIdx.x == 0) {
        unsigned* bar = b.bar;
        __builtin_amdgcn_s_waitcnt(0);
        unsigned nloc = b.st[0], nx = b.st[1];
        if (nloc == 0u) { xcd_barrier_complete(bar, b.x, nloc, nx); b.st[0] = nloc; b.st[1] = nx; }
        const unsigned old = xb_add(&bar[XB_XSUB(b.x)], 1u);
        const unsigned gen = old / nloc;
        if (old + 1u == (gen + 1u) * nloc) {
            __builtin_amdgcn_fence(__ATOMIC_RELEASE, "agent");
            asm volatile("s_waitcnt vmcnt(0)" ::: "memory");
            const unsigned og = xb_add(&bar[XB_TOP], 1u);
            const unsigned tg = og / nx;
            if (og + 1u == (tg + 1u) * nx) xb_add(&bar[XB_TOPGEN], 1u);
            else XB_SPIN(xb_ld(&bar[XB_TOPGEN]) == tg, bar);
            __builtin_amdgcn_fence(__ATOMIC_ACQUIRE, "agent");
            xb_add(&bar[XB_XGEN(b.x)], 1u);
            asm volatile("s_waitcnt vmcnt(0)" ::: "memory");
        } else {
            XB_SPIN(xb_ld(&bar[XB_XGEN(b.x)]) == gen, bar);
            __builtin_amdgcn_fence(__ATOMIC_ACQUIRE, "agent");
            asm volatile("s_waitcnt vmcnt(0)" ::: "memory");
        }
    }
    __syncthreads();
}


template <class TileFn>
DI void h_stream(const Params& p, int l, TileFn tilefn) {
  const bf16_t* hbp = (const bf16_t*)(p.ws + O_HB);
  const bf16_t* w1 = (const bf16_t*)(p.ws + wset(l) + O_WFF1);
  bf16_t* hid = (bf16_t*)(p.ws + O_HID);
  gemm_stream<1024, 1024, 1024>(
      [&](int i, const bf16_t*& A, const bf16_t*& B) {
        int rt, ct;
        if (!tilefn(i, rt, ct)) return false;
        A = hbp + (size_t)rt * 256 * 1024; B = w1 + (size_t)ct * 256 * 1024; return true;
      },
      [&](int i, acc_t& acc) {
        int rt, ct;
        tilefn(i, rt, ct);
        store_bf16_tile<1>(acc, hid + (size_t)rt * 256 * HLD + ct * 256, HLD);
      });
}
DI void i_tile(const Params& p, int l, int rt, int ct) {
  const bf16_t* hid = (const bf16_t*)(p.ws + O_HID);
  const bf16_t* w2 = (const bf16_t*)(p.ws + wset(l) + O_WFF2);
  float* xp = xrow_ptr(p, rt * 256) + ct * 256;
  const float* gate = (const float*)(p.ws + O_MOD) + (size_t)l * 9 * 6144 + (size_t)modrow_of(rt * 256) * 6144 + 5 * 1024 + ct * 256;
  gemm_stream<HLD, 4096, 4096>(
      [&](int i, const bf16_t*& A, const bf16_t*& B) {
        if (i > 0) return false;
        A = hid + (size_t)rt * 256 * HLD; B = w2 + (size_t)ct * 256 * 4096; return true;
      },
      [&](int i, acc_t& acc) { residual_tile(acc, xp, gate); });
}
DI void publish_cnt(unsigned* c) {
  asm volatile("s_waitcnt vmcnt(0)" ::: "memory");
  __syncthreads();
  if (threadIdx.x == 0) {
    __builtin_amdgcn_fence(__ATOMIC_RELEASE, "agent");
    asm volatile("s_waitcnt vmcnt(0)" ::: "memory");
    (void)xb_add(c, 1u);
  }
}
DI void wait_cnt(unsigned* c, unsigned need, unsigned* barw) {
  if (threadIdx.x == 0) {
    XB_SPIN(xb_ld(c) < need, barw);
    __builtin_amdgcn_fence(__ATOMIC_ACQUIRE, "agent");
    asm volatile("s_waitcnt vmcnt(0)" ::: "memory");
  }
  __syncthreads();
}
DI void e_tile(const Params& p, int l, int rt, int ct) {
  const bf16_t* ymlap = (const bf16_t*)(p.ws + O_YMLA) + (size_t)rt * 256 * 512;
  const bf16_t* ynap = (const bf16_t*)(p.ws + O_YNA) + (size_t)rt * 256 * 512;
  const bf16_t* wmo = (const bf16_t*)(p.ws + wset(l) + O_WMO) + (size_t)ct * 256 * 512;
  const bf16_t* wno = (const bf16_t*)(p.ws + wset(l) + O_WNO) + (size_t)ct * 256 * 512;
  bf16_t* yt = (bf16_t*)(p.ws + O_Y) + (size_t)rt * 256 * 1024 + ct * 256;
  const bool cpan = (rt % 9 == 0);
  const bf16_t* gt = cpan ? (const bf16_t*)(p.ws + O_GATEC) + (size_t)(rt / 9) * 256 * 2048 + ct * 256
                          : (const bf16_t*)(p.ws + O_GATE) + (size_t)rt * 256 * PBW + ct * 256;
  const int ldg = cpan ? 2048 : PBW;
  gemm_stream<512, 512, 512>(
      [&](int i, const bf16_t*& A, const bf16_t*& B) {
        if (i > 1) return false;
        A = i ? ynap : ymlap; B = i ? wno : wmo; return true;
      },
      [&](int i, acc_t& acc) {
        if (i & 1) gated_tile<true>(acc, yt, 1024, gt + 1024, ldg);
        else gated_tile<false>(acc, yt, 1024, gt, ldg);
      });
}
DI void f_tile(const Params& p, int l, int rt, int ct) {
  const bf16_t* yp = (const bf16_t*)(p.ws + O_Y) + (size_t)rt * 256 * 1024;
  const bf16_t* wo = (const bf16_t*)(p.ws + wset(l) + O_WOUT) + (size_t)ct * 256 * 1024;
  float* xp = xrow_ptr(p, rt * 256) + ct * 256;
  const float* gate = (const float*)(p.ws + O_MOD) + (size_t)l * 9 * 6144 + (size_t)modrow_of(rt * 256) * 6144 + 2 * 1024 + ct * 256;
  const float* xin = l == 0 ? xrow_src(p, rt * 256, true) + ct * 256 : nullptr;
  gemm_stream<1024, 1024, 1024>(
      [&](int i, const bf16_t*& A, const bf16_t*& B) {
        if (i > 0) return false;
        A = yp; B = wo; return true;
      },
      [&](int i, acc_t& acc) { residual_tile(acc, xp, gate, xin); });
}
__global__ void __launch_bounds__(512, 2) fwd_megakernel(Params p) {
  cg::grid_group grid = cg::this_grid();
  char* ws = p.ws;
  const int G = gridDim.x;
  volatile LAS unsigned* xst = (volatile LAS unsigned*)(smem + 131072);
  if (threadIdx.x < 4) xst[threadIdx.x] = 0u;
  __syncthreads();
  const XcdBarrier xb = xcd_barrier_post((unsigned*)(ws + O_BAR), xst);

  phase0(p, smem);
  convert_weights(p, 0, smem, blockIdx.x, gridDim.x, 0, 1 << 30);
  zero_wp_pad(p, 0);
  xcd_barrier(xb);
  if (p.ws == nullptr) grid.sync();

  for (int l = 0; l < NLAYER; ++l) {
    const bool last = (l == NLAYER - 1);

    phase_norm(p, l, p.g_attn + l * 1024, 0, false, l == 0);
    xcd_barrier(xb);

    {
      const bf16_t* hbp = (const bf16_t*)(wsop(p) + O_HB);
      const bf16_t* wp = (const bf16_t*)(wsop(p) + wset(l) + O_WP);
      bf16_t* pbp = (bf16_t*)(wsop(p) + O_PB);
      const int b0 = blockIdx.x;
      const bf16_t* wgp = (const bf16_t*)(wsop(p) + wset(l) + O_WG);
      bf16_t* gcp = (bf16_t*)(wsop(p) + O_GATEC);
      const int nB = NRT * 11, nAll = nB + (last ? 0 : 64);
      gemm_stream<1024, 1024, 1024>(
          [&](int i, const bf16_t*& A, const bf16_t*& B) {
            const int t = b0 + i * G;
            if (t >= nAll) return false;
            if (t < nB) { A = hbp + (size_t)(t % NRT) * 256 * 1024; B = wp + (size_t)(t / NRT) * 256 * 1024; }
            else { const int j = t - nB; A = hbp + (size_t)(9 * (j >> 3)) * 256 * 1024; B = wgp + (size_t)(j & 7) * 256 * 1024; }
            return true;
          },
          [&](int i, acc_t& acc) {
            const int t = b0 + i * G;
            if (t < nB) store_bf16_tile<0>(acc, pbp + (size_t)(t % NRT) * 256 * PBW + (t / NRT) * 256, PBW);
            else { const int j = t - nB; store_bf16_tile<2>(acc, gcp + (size_t)(j >> 3) * 256 * 2048 + (j & 7) * 256, 2048); }
          });
      if (!last && blockIdx.x >= 88) convert_weights(p, l + 1, smem, (int)blockIdx.x - 88, 168, 0, 1400);
    }
    xcd_barrier(xb);

    {
      const bf16_t* pbp = (const bf16_t*)(wsop(p) + O_PB);
      const bf16_t* wuq = (const bf16_t*)(wsop(p) + wset(l) + O_WUQ);
      const bf16_t* wukv = (const bf16_t*)(wsop(p) + wset(l) + O_WUKV);
      bf16_t* qkp = (bf16_t*)(wsop(p) + O_QK2);
      const int b0 = blockIdx.x, b1 = (blockIdx.x + 40) % G;
      gemm_stream<PBW, 768, 768>(
          [&](int i, const bf16_t*& A, const bf16_t*& B) {
            const int t = b0 + i * G;
            if (t >= NRT * 3) return false;
            A = pbp + (size_t)(t % NRT) * 256 * PBW; B = wuq + (size_t)(t / NRT) * 256 * 768; return true;
          },
          [&](int i, acc_t& acc) {
            const int t = b0 + i * G;
            store_bf16_tile<0>(acc, qkp + (size_t)(t % NRT) * 256 * QKW + (t / NRT) * 256, QKW);
          });
      gemm_stream<PBW, 256, 256>(
          [&](int i, const bf16_t*& A, const bf16_t*& B) {
            const int t = b1 + i * G;
            if (t >= NRT * 4) return false;
            A = pbp + (size_t)(t % NRT) * 256 * PBW + 768; B = wukv + (size_t)(t / NRT) * 256 * 256; return true;
          },
          [&](int i, acc_t& acc) {
            const int t = b1 + i * G;
            store_bf16_tile<0>(acc, qkp + (size_t)(t % NRT) * 256 * QKW + 768 + (t / NRT) * 256, QKW);
          });
    }
    for (int t = blockIdx.x; t < TT / 16; t += G) rowstats_item(p, t);
    xcd_barrier(xb);

    {
      const int tidf = otid(), w = tidf >> 6;
      {
        const float* tabg = (const float*)(wsop(p) + O_TAB);
        float* tl = (float*)smem;
        for (int i = tidf; i < 1024; i += 512) tl[i] = tabg[i];
        __syncthreads();
      }
      for (int wi = blockIdx.x * 8 + w; wi < 288 * 8 * 3; wi += G * 8) finalize_wave_item(p, l, wi);
    }
    xcd_barrier(xb);

    phase_attn(p, l, last, smem);
    xcd_barrier(xb);

    {
      unsigned* ce = (unsigned*)(wsop(p) + O_CE);
      unsigned* barw = (unsigned*)(wsop(p) + O_BAR);
      const int b = blockIdx.x;
      const unsigned need = 4u * (unsigned)(l + 1);
      if (!last) zero_wp_pad(p, l + 1);
      {
        const int li = b & 63, ct = b >> 6, rt = (li >> 3) * 9 + 1 + (li & 7);
        e_tile(p, l, rt, ct);
        publish_cnt(ce + rt * 16);
      }
      if (!last && b < 32) {
        const int rt = 9 * (b >> 2), ct = b & 3;
        e_tile(p, l, rt, ct);
        publish_cnt(ce + rt * 16);
        wait_cnt(ce + rt * 16, need, barw);
        f_tile(p, l, rt, ct);
      } else {
        {
          const int id = last ? b : b - 32, panel = id >> 2, ct = id & 3, rt = (panel >> 3) * 9 + 1 + (panel & 7);
          wait_cnt(ce + rt * 16, need, barw);
          f_tile(p, l, rt, ct);
        }
        if (!last) {
          if (b < 64) {
            const int id = 224 + (b - 32), panel = id >> 2, ct = id & 3, rt = (panel >> 3) * 9 + 1 + (panel & 7);
            wait_cnt(ce + rt * 16, need, barw);
            f_tile(p, l, rt, ct);
          } else {
            convert_weights(p, l + 1, smem, b - 64, 192, 1400, 1 << 30);
          }
        }
      }
      xcd_barrier(xb);
    }

    phase_norm(p, l, p.g_mlp + l * 1024, 3, last, false);
    xcd_barrier(xb);

    {
      unsigned* hcnt = (unsigned*)(wsop(p) + O_BAR + 14336);
      unsigned* barw = (unsigned*)(wsop(p) + O_BAR);
      const int b = blockIdx.x;
      auto publish = [&](int rtc) {
        asm volatile("s_waitcnt vmcnt(0)" ::: "memory");
        __syncthreads();
        if (threadIdx.x == 0) {
          __builtin_amdgcn_fence(__ATOMIC_RELEASE, "agent");
          asm volatile("s_waitcnt vmcnt(0)" ::: "memory");
          (void)xb_add(&hcnt[rtc * 16], 1u);
        }
      };
      if (last) {
        h_stream(p, l, [&](int i, int& rt, int& ct) { return tile_of(b + i * G, true, 16, rt, ct); });
      } else if (b < 32) {
        h_stream(p, l, [&](int i, int& rt, int& ct) { if (i > 0) return false; rt = 9 * (b >> 4); ct = b & 15; return true; });
        publish(b >> 4);
        const int rtc = b >> 2;
        if (threadIdx.x == 0) {
          XB_SPIN(xb_ld(&hcnt[rtc * 16]) < 16u * (unsigned)(l + 1), barw);
          __builtin_amdgcn_fence(__ATOMIC_ACQUIRE, "agent");
          asm volatile("s_waitcnt vmcnt(0)" ::: "memory");
        }
        __syncthreads();
        i_tile(p, l, 9 * rtc, b & 3);
      } else {
        int first = 0;
        if (b - 32 < 96) {
          const int c = 32 + (b - 32);
          h_stream(p, l, [&](int i, int& rt, int& ct) { if (i > 0) return false; rt = 9 * (c >> 4); ct = c & 15; return true; });
          publish(c >> 4);
          first = 1;
        }
        h_stream(p, l, [&](int i, int& rt, int& ct) {
          const int ii = i + first;
          if (ii >= 5) return false;
          const int m = (b - 32) + 224 * ii - 96, li = m & 63;
          rt = (li >> 3) * 9 + 1 + (li & 7); ct = m >> 6; return true;
        });
      }
    }
    xcd_barrier(xb);

    {
      const bool lat_only = true;
      for (int t = blockIdx.x;; t += G) {
        int rt, ct;
        if (!tile_of(t, lat_only, 4, rt, ct)) break;
        i_tile(p, l, rt, ct);
      }
    }
    if (!last) xcd_barrier(xb);
  }
}

extern "C" void kernel_launch(void* const* d_in, const int* in_sizes, int n_in, void* d_out, int out_size, void* d_ws, size_t ws_size, hipStream_t stream) {
  static int grid_blocks = 0;
  if (!grid_blocks) {
    int dev = 0, cus = 0, per_cu = 0;
    hipGetDevice(&dev);
    hipDeviceGetAttribute(&cus, hipDeviceAttributeMultiprocessorCount, dev);
    (void)hipFuncSetAttribute((const void*)fwd_megakernel, hipFuncAttributeMaxDynamicSharedMemorySize, 131072 + 16);
    hipOccupancyMaxActiveBlocksPerMultiprocessor(&per_cu, fwd_megakernel, 512, 131072 + 16);
    if (per_cu > 1) per_cu = 1;
    if (per_cu < 1) per_cu = 1;
    grid_blocks = cus * per_cu;
    if (grid_blocks != 256) { fprintf(stderr, "this kernel's static schedules need exactly 256 co-resident workgroups (got %d)\n", grid_blocks); grid_blocks = 256; }
  }
  if (ws_size < O_END) { fprintf(stderr, "workspace too small: %zu < %zu\n", ws_size, (size_t)O_END); return; }
  Params p{};
  const float** f = (const float**)&p;
  for (int i = 0; i < 23; ++i) f[i] = (const float*)d_in[i];
  p.out = (float*)d_out;
  p.ws = (char*)d_ws;
  void* args[] = {&p};
  (void)hipMemsetAsync((char*)d_ws + O_BAR, 0, 32768, stream);
  hipError_t e = hipLaunchCooperativeKernel((void*)fwd_megakernel, dim3(grid_blocks), dim3(512), args, 131072 + 16, stream);
  if (e != hipSuccess) fprintf(stderr, "cooperative launch failed: %s (grid %d)\n", hipGetErrorString(e), grid_blocks);
}
```
